# Optimizing an MI355X kernel written in HIP

```python
import jax, jax.numpy as jnp
from jax import lax
import numpy as np

D_MODEL = 1024
BATCH = 2
SEQ = 16384
DEPTH = 2

N_A = DEPTH // 2
N_B = DEPTH - N_A
N_DENSE = (DEPTH + 1) // 2
N_MOE = DEPTH // 2

POOL_WINDOWS = (2, 4, 8, 16)
N_POOL_GROUPS = len(POOL_WINDOWS)
POOL_GROUP = D_MODEL // N_POOL_GROUPS

HEAD_DIM = 64
N_HEADS = D_MODEL // HEAD_DIM
Q_BLOCK = 128
NEG_INF = -1e30

D_FF_DENSE = ((8 * D_MODEL // 3 + 255) // 256) * 256
N_EXPERTS = 8
TOP_K = 2
D_FF_EXPERT = 7 * D_MODEL // 2

EPS = 1e-5

kernel_name = "yoco_pool_fox_moe_hybrid"


def rmsnorm(x, g):
    xf = x.astype(jnp.float32)
    y = xf * lax.rsqrt(jnp.mean(xf * xf, axis=-1, keepdims=True) + EPS)
    return (y * g.astype(jnp.float32)).astype(x.dtype)


def causal_multiscale_pool(h, w_grp, scale):
    B, S, D = h.shape
    hf = h.astype(jnp.float32).reshape(B, S, N_POOL_GROUPS, POOL_GROUP)
    csum = jnp.pad(jnp.cumsum(hf, axis=1), ((0, 0), (1, 0), (0, 0), (0, 0)))
    pos = jnp.arange(S)
    pooled = []
    for g, w in enumerate(POOL_WINDOWS):
        cg = csum[:, :, g]
        lo = jnp.maximum(pos + 1 - w, 0)
        win_sum = cg[:, 1:] - cg[:, lo]
        cnt = (pos + 1 - lo).astype(jnp.float32)
        pooled.append(win_sum / cnt[None, :, None])
    pooled = jnp.stack(pooled, axis=2) - hf
    mixed = jnp.einsum('bsgc,gcd->bsgd', pooled, w_grp.astype(jnp.float32))
    return (mixed.reshape(B, S, D) * scale.astype(jnp.float32)).astype(h.dtype)


def forgetting_attention(q, k, v, fcum):
    B, H, S, Dh = q.shape
    n_blocks = S // Q_BLOCK
    qf = q.astype(jnp.float32) * (Dh ** -0.5)
    kf = k.astype(jnp.float32)
    vf = v.astype(jnp.float32)
    offs = jnp.arange(Q_BLOCK)

    def one_query_block(i):
        q0 = i * Q_BLOCK
        qb = lax.dynamic_slice_in_dim(qf, q0, Q_BLOCK, axis=2)
        fq = lax.dynamic_slice_in_dim(fcum, q0, Q_BLOCK, axis=2)
        qpos = q0 + offs

        def body(j, carry):
            m, l, acc = carry
            k0 = j * Q_BLOCK
            kb = lax.dynamic_slice_in_dim(kf, k0, Q_BLOCK, axis=2)
            vb = lax.dynamic_slice_in_dim(vf, k0, Q_BLOCK, axis=2)
            fk = lax.dynamic_slice_in_dim(fcum, k0, Q_BLOCK, axis=2)
            kpos = k0 + offs
            s = (jnp.einsum('bhqd,bhkd->bhqk', qb, kb)
                 + fq[..., :, None] - fk[..., None, :])
            s = jnp.where(qpos[:, None] >= kpos[None, :], s, NEG_INF)
            m_new = jnp.maximum(m, jnp.max(s, axis=-1))
            p = jnp.exp(s - m_new[..., None])
            corr = jnp.exp(m - m_new)
            l = l * corr + jnp.sum(p, axis=-1)
            acc = acc * corr[..., None] + jnp.einsum('bhqk,bhkd->bhqd', p, vb)
            return m_new, l, acc

        init = (jnp.full((B, H, Q_BLOCK), NEG_INF, jnp.float32),
                jnp.zeros((B, H, Q_BLOCK), jnp.float32),
                jnp.zeros((B, H, Q_BLOCK, Dh), jnp.float32))
        _, l, acc = lax.fori_loop(0, i + 1, body, init)
        return acc / l[..., None]

    out = lax.map(one_query_block, jnp.arange(n_blocks))
    out = jnp.moveaxis(out, 0, 2).reshape(B, H, S, Dh)
    return out.astype(q.dtype)


def swiglu(h, w_gate, w_up, w_down):
    return (jax.nn.silu(h @ w_gate) * (h @ w_up)) @ w_down


def moe_swiglu(h, w_router, e_gate, e_up, e_down):
    logits = (h @ w_router).astype(jnp.float32)
    top_v, top_i = lax.top_k(logits, TOP_K)
    wts = jax.nn.softmax(top_v, axis=-1)
    gates = jnp.sum(jax.nn.one_hot(top_i, N_EXPERTS, dtype=jnp.float32)
                    * wts[..., None], axis=-2)
    out = jnp.zeros(h.shape, jnp.float32)
    for e in range(N_EXPERTS):
        y = swiglu(h, e_gate[e], e_up[e], e_down[e]).astype(jnp.float32)
        out = out + gates[..., e:e + 1] * y
    return out.astype(h.dtype)


def setup_inputs(seed: int = 0) -> dict:
    key = jax.random.key(seed)
    ks = jax.random.split(key, 20)
    f32 = jnp.float32
    D, H = D_MODEL, N_HEADS

    def nrm(k, shape, fan_in):
        return jax.random.normal(k, shape, f32) * (fan_in ** -0.5)

    def gain(k, shape):
        return 1.0 + 0.02 * jax.random.normal(k, shape, f32)

    b_f = jnp.linspace(1.0, 5.0, H, dtype=f32) + 0.1 * jax.random.normal(ks[7], (H,), f32)
    return {
        "x": jax.random.normal(ks[0], (BATCH, SEQ, D), f32),
        "norm_mix": gain(ks[1], (DEPTH, D)),
        "norm_ffn": gain(ks[2], (DEPTH, D)),
        "pool_w": nrm(ks[3], (N_A, N_POOL_GROUPS, POOL_GROUP, POOL_GROUP), POOL_GROUP),
        "pool_scale": gain(ks[4], (N_A, D)),
        "norm_kv": gain(ks[5], (D,)),
        "w_kv": nrm(ks[6], (D, 2 * D + H), D),
        "b_f": b_f,
        "w_q": nrm(ks[8], (N_B, D, D), D),
        "w_o": nrm(ks[9], (N_B, D, D), D),
        "ffn_gate": nrm(ks[10], (N_DENSE, D, D_FF_DENSE), D),
        "ffn_up": nrm(ks[11], (N_DENSE, D, D_FF_DENSE), D),
        "ffn_down": nrm(ks[12], (N_DENSE, D_FF_DENSE, D), D_FF_DENSE),
        "w_router": nrm(ks[13], (N_MOE, D, N_EXPERTS), D),
        "exp_gate": nrm(ks[14], (N_MOE, N_EXPERTS, D, D_FF_EXPERT), D),
        "exp_up": nrm(ks[15], (N_MOE, N_EXPERTS, D, D_FF_EXPERT), D),
        "exp_down": nrm(ks[16], (N_MOE, N_EXPERTS, D_FF_EXPERT, D), D_FF_EXPERT),
        "norm_final": gain(ks[17], (D,)),
    }


def reference(x, norm_mix, norm_ffn, pool_w, pool_scale, norm_kv, w_kv, b_f,
              w_q, w_o, ffn_gate, ffn_up, ffn_down, w_router, exp_gate, exp_up,
              exp_down, norm_final):
    B, S, D = x.shape
    H, Dh = N_HEADS, HEAD_DIM
    k_sh = v_sh = fcum_sh = None
    for l in range(DEPTH):
        h = rmsnorm(x, norm_mix[l])
        if l < N_A:
            x = x + causal_multiscale_pool(h, pool_w[l], pool_scale[l])
        else:
            if l == N_A:
                hkv = rmsnorm(x, norm_kv)
                kvf = hkv @ w_kv
                k_sh = kvf[..., :D].reshape(B, S, H, Dh).transpose(0, 2, 1, 3)
                v_sh = kvf[..., D:2 * D].reshape(B, S, H, Dh).transpose(0, 2, 1, 3)
                log_f = jax.nn.log_sigmoid(kvf[..., 2 * D:].astype(jnp.float32)
                                           + b_f.astype(jnp.float32))
                fcum_sh = jnp.cumsum(log_f, axis=1).transpose(0, 2, 1)
            b = l - N_A
            q = (h @ w_q[b]).reshape(B, S, H, Dh).transpose(0, 2, 1, 3)
            o = forgetting_attention(q, k_sh, v_sh, fcum_sh)
            x = x + o.transpose(0, 2, 1, 3).reshape(B, S, D) @ w_o[b]
        h = rmsnorm(x, norm_ffn[l])
        if l % 2 == 0:
            i = l // 2
            x = x + swiglu(h, ffn_gate[i], ffn_up[i], ffn_down[i])
        else:
            i = l // 2
            x = x + moe_swiglu(h, w_router[i], exp_gate[i], exp_up[i], exp_down[i])
    return rmsnorm(x, norm_final)
```

```cpp
#include <hip/hip_runtime.h>
#include <cstdint>
#include <cstdio>

typedef unsigned short bf16;
constexpr int NB = 2, SEQ = 16384, D = 1024, M = NB * SEQ, NH = 16, HD = 64, FFD = 2816, NE = 8, FFE = 3584, FFH = 1792;
constexpr int KVW = 2 * D + NH;
constexpr float EPS = 1e-5f, LOG2E = 1.4426950408889634f, C2 = 0.125f * LOG2E;
constexpr int NTILE = SEQ / 256;
constexpr int MAXSLOT = 2 * M + NE * 256;
constexpr int MAXT = MAXSLOT / 256;

constexpr size_t MiB = 1u << 20;
constexpr size_t WS_CTL = 0;
constexpr size_t WS_STATS = 1 * MiB;
constexpr size_t WS_RINV3 = 3 * MiB + 128 * 1024;
constexpr size_t WS_FL = 4 * MiB;
constexpr size_t WS_FTOT = 6 * MiB;
constexpr size_t WS_TOKE = 6 * MiB + 64 * 1024;
constexpr size_t WS_TOKW = WS_TOKE + 256 * 1024;
constexpr size_t WS_CHIST = WS_TOKW + 256 * 1024;
constexpr size_t WS_TILEE = WS_CHIST + 8192;
constexpr size_t WS_SLOTTOK = 7 * MiB;
constexpr size_t WS_SLOTINFO = WS_SLOTTOK + 512 * 1024;

__device__ __forceinline__ float bf2f(bf16 v) { return __builtin_bit_cast(float, (unsigned)v << 16); }
__device__ __forceinline__ bf16 f2bf(float f) { unsigned u = __builtin_bit_cast(unsigned, f); return (bf16)((u + 0x7fffu + ((u >> 16) & 1u)) >> 16); }
__device__ __forceinline__ float wave_sum(float v) {
#pragma unroll
    for (int o = 1; o < 64; o <<= 1) v += __shfl_xor(v, o);
    return v;
}

#define LAS __attribute__((address_space(3)))
#define GAS __attribute__((address_space(1)))
typedef unsigned v4u __attribute__((ext_vector_type(4)));
typedef float f32x4 __attribute__((ext_vector_type(4)));
typedef float f32x2 __attribute__((ext_vector_type(2)));
typedef short bf16x8 __attribute__((ext_vector_type(8)));
#define LDS_WAIT() asm volatile("s_waitcnt lgkmcnt(0)" ::: "memory")
#define VM_WAIT() asm volatile("s_waitcnt vmcnt(0)" ::: "memory")
__device__ __forceinline__ unsigned pk2(float lo, float hi) { return (unsigned)f2bf(lo) | ((unsigned)f2bf(hi) << 16); }

__device__ __forceinline__ int lane_id() { return (int)__builtin_amdgcn_mbcnt_hi(~0u, __builtin_amdgcn_mbcnt_lo(~0u, 0u)); }
namespace pg8 {
#define PG8_LAS __attribute__((address_space(3)))
typedef unsigned short bf16_t;
typedef unsigned u32x4 __attribute__((ext_vector_type(4)));
constexpr int BM = 256, BK = 64, HALF = 128, HTB = HALF * BK * 2  , STAGE_BYTES = 8 * HTB, NXCD = 8, WGM = 8;
__host__ __device__ __forceinline__ int lds_byte(int r, int c) { const int st = (r >> 4) * 2 + (c >> 5), rr = r & 15, cc = c & 31, ob = rr * 64 + cc * 2; return st * 1024 + (ob ^ (((ob >> 9) & 1) << 5)); }
__host__ __device__ __forceinline__ void stage_rc(int b, int& R, int& C) { const int st = b / 1024, sb = b % 1024, swz = sb ^ (((sb >> 9) & 1) << 5); R = (st >> 1) * 16 + swz / 64; C = (st & 1) * 32 + (swz % 64) / 2; }
__host__ __device__ __forceinline__ int perm32(int rho) { const int n = rho >> 4, i = rho & 15; return 8 * (i >> 2) + 4 * n + (i & 3); }

struct Unit { int pm, pn; unsigned aoff, boff; };
struct Gemm { const bf16_t* A; const bf16_t* Bt; int lda, ldb, K; };

struct RegOrder {
    static constexpr bool GATHER = false;
    int nM, nN, nwg, G, c; unsigned a_tile, a_pn, b_tile;
    __device__ __forceinline__ void init(int M_, int N_, int G_, int c_, int lda, int ldb, unsigned a_pn_) { nM = M_ / BM; nN = N_ / BM; nwg = nM * nN; G = G_; c = c_; a_tile = 256u * (unsigned)lda * 2u; b_tile = 256u * (unsigned)ldb * 2u; a_pn = a_pn_; }
    __device__ __forceinline__ bool next(int i, Unit& u) const {
        const long L = (long)i * G + c; if (L >= nwg) return false;
        int wgid = (int)L; { const int q = nwg / NXCD, r = nwg % NXCD, xcd = wgid % NXCD, off = wgid / NXCD; wgid = (xcd < r ? xcd * (q + 1) : r * (q + 1) + (xcd - r) * q) + off; }
        const int nig = WGM * nN, gid = wgid / nig, fm = gid * WGM, gsz = (nM - fm) < WGM ? (nM - fm) : WGM;
        u.pm = fm + ((wgid % nig) % gsz); u.pn = (wgid % nig) / gsz; u.aoff = (unsigned)u.pm * a_tile + (unsigned)u.pn * a_pn; u.boff = (unsigned)u.pn * b_tile; return true;
    }
    __device__ __forceinline__ int tok(int) const { return 0; }
};
template <bool G_> struct MoeOrder {
    static constexpr bool GATHER = G_;
    int ntiles, npn, G, c; const PG8_LAS int* tilee; const int* list; unsigned a_tile, e_stride, b_tile; int GM;
    __device__ __forceinline__ bool next(int i, Unit& u) const {
        if (G % NXCD != 0) { const int L = i * G + c; if (L >= ntiles * npn) return false; u.pn = L / ntiles; u.pm = L - u.pn * ntiles; }
        else {
            const int x = c % NXCD, j = c / NXCD, nw = G / NXCD, t_lo = x * ntiles / NXCD, nt_x = (x + 1) * ntiles / NXCD - t_lo, q = i * nw + j;
            if (q >= nt_x * npn) return false;
            const int per = GM * npn, nfull = nt_x / GM, grp = q / per;
            int base, gsz, r;
            if (grp < nfull) { base = grp * GM; gsz = GM; r = q - grp * per; } else { base = nfull * GM; gsz = nt_x - base; r = q - nfull * per; }
            const int pn = r / gsz; u.pn = pn; u.pm = t_lo + base + (r - pn * gsz);
        }
        const int e = tilee[u.pm]; u.aoff = (unsigned)u.pm * a_tile; u.boff = (unsigned)e * e_stride + (unsigned)u.pn * b_tile; return true;
    }
    __device__ __forceinline__ int tok(int slot) const { return list[slot]; }
};

__device__ __forceinline__ unsigned cvt_pk_bf16(float lo, float hi) { unsigned r; asm volatile("v_cvt_pk_bf16_f32 %0, %1, %2" : "=v"(r) : "v"(lo), "v"(hi)); return r; }
__device__ __forceinline__ float rinv_from_stats(const float* stats, int row) {
    const f32x4* p = (const f32x4*)(stats + (size_t)row * 16); const f32x4 a = p[0], b = p[1], c = p[2], d = p[3];
    const float s = (((a[0] + a[1]) + (a[2] + a[3])) + ((b[0] + b[1]) + (b[2] + b[3]))) + (((c[0] + c[1]) + (c[2] + c[3])) + ((d[0] + d[1]) + (d[2] + d[3])));
    return 1.0f / sqrtf(s * (1.0f / 1024.0f) + 1e-5f);
}
__device__ __forceinline__ float clamp8(float v) { return fminf(fmaxf(v, -448.f), 448.f); }
__device__ __forceinline__ unsigned pk4_fp8(float a, float b, float c, float d) {
    int w = __builtin_amdgcn_cvt_pk_fp8_f32(clamp8(a), clamp8(b), 0, false); w = __builtin_amdgcn_cvt_pk_fp8_f32(clamp8(c), clamp8(d), w, true); return (unsigned)w; }
__device__ __forceinline__ float silu_mul(float g, float u) { return g * u * __builtin_amdgcn_rcpf(1.0f + __builtin_amdgcn_exp2f(-1.4426950408889634f * g)); }
__device__ __forceinline__ float silu_mul_raw(float a, float b, float c1, float c3) { const float e = __builtin_amdgcn_exp2f(a * c1); return (a * b) * __builtin_amdgcn_rcpf(__builtin_fmaf(e, c3, c3)); }

struct EpiRes {
    static constexpr bool PERM = true;
    const float* xf; bf16_t* xb; float* stats; unsigned char* x8;
    __device__ __forceinline__ void operator()(const f32x4 (&acc)[2][2][4][2], const Unit& u, int wr, int wc, int fr, int fq) const {
        const size_t o0 = (size_t)(u.pm * BM + wr * 64 + fr) * 1024 + u.pn * BM + wc * 32 + 8 * fq;
#pragma unroll
        for (int ai = 0; ai < 2; ++ai) {
            if (xf) {
#pragma unroll
                for (int mp = 0; mp < 2; ++mp) { f32x4 b[2][2][2];
#pragma unroll
                    for (int mm = 0; mm < 2; ++mm)
#pragma unroll
                        for (int bj = 0; bj < 2; ++bj) { const size_t o = o0 + (size_t)(ai * HALF + (2 * mp + mm) * 16) * 1024 + bj * HALF; b[mm][bj][0] = *(const f32x4*)(xf + o); b[mm][bj][1] = *(const f32x4*)(xf + o + 4); }
#pragma unroll
                    for (int mm = 0; mm < 2; ++mm) row_out(acc, u, wr, wc, fr, fq, ai, 2 * mp + mm, o0, b[mm][0][0], b[mm][0][1], b[mm][1][0], b[mm][1][1]); }
            } else { u32x4 w[4][2];
#pragma unroll
                for (int m = 0; m < 4; ++m)
#pragma unroll
                    for (int bj = 0; bj < 2; ++bj) w[m][bj] = *(const u32x4*)(xb + o0 + (size_t)(ai * HALF + m * 16) * 1024 + bj * HALF);
#pragma unroll
                for (int m = 0; m < 4; ++m) { f32x4 b[2][2];
#pragma unroll
                    for (int bj = 0; bj < 2; ++bj) { const u32x4 p = w[m][bj];
                        b[bj][0] = (f32x4){__uint_as_float(p.x << 16), __uint_as_float(p.x & 0xffff0000u), __uint_as_float(p.y << 16), __uint_as_float(p.y & 0xffff0000u)};
                        b[bj][1] = (f32x4){__uint_as_float(p.z << 16), __uint_as_float(p.z & 0xffff0000u), __uint_as_float(p.w << 16), __uint_as_float(p.w & 0xffff0000u)}; }
                    row_out(acc, u, wr, wc, fr, fq, ai, m, o0, b[0][0], b[0][1], b[1][0], b[1][1]); }
            }
        }
    }
    __device__ __forceinline__ void row_out(const f32x4 (&acc)[2][2][4][2], const Unit& u, int wr, int wc, int fr, int fq, int ai, int m, size_t o0, f32x4 b00, f32x4 b01, f32x4 b10, f32x4 b11) const {
        const int row = u.pm * BM + ai * HALF + wr * 64 + m * 16 + fr; float ss = 0.f;
#pragma unroll
        for (int bj = 0; bj < 2; ++bj) { const size_t o = o0 + (size_t)(ai * HALF + m * 16) * 1024 + bj * HALF; const f32x4 v0 = acc[ai][bj][m][0] + (bj ? b10 : b00), v1 = acc[ai][bj][m][1] + (bj ? b11 : b01);
            ss += ((v0[0] * v0[0] + v0[1] * v0[1]) + (v0[2] * v0[2] + v0[3] * v0[3])) + ((v1[0] * v1[0] + v1[1] * v1[1]) + (v1[2] * v1[2] + v1[3] * v1[3]));
            u32x4 r; r.x = cvt_pk_bf16(v0[0], v0[1]); r.y = cvt_pk_bf16(v0[2], v0[3]); r.z = cvt_pk_bf16(v1[0], v1[1]); r.w = cvt_pk_bf16(v1[2], v1[3]);
            *(u32x4*)(xb + o) = r;
            if (x8) { uint2 p; p.x = pk4_fp8(v0[0], v0[1], v0[2], v0[3]); p.y = pk4_fp8(v1[0], v1[1], v1[2], v1[3]); *(uint2*)(x8 + o) = p; } }
        ss += __shfl_xor(ss, 16); ss += __shfl_xor(ss, 32);
        if (fq == 0) stats[(size_t)row * 16 + u.pn * 4 + wc] = ss;
    }
};
__device__ __forceinline__ void rinv8_from_stats(const float* stats, int row0  , int fq, float (&rs)[2][4]) {
    f32x4 q[2][4];
#pragma unroll
    for (int ai = 0; ai < 2; ++ai)
#pragma unroll
        for (int m = 0; m < 4; ++m) q[ai][m] = *(const f32x4*)(stats + (size_t)(row0 + ai * HALF + m * 16) * 16 + 4 * fq);
#pragma unroll
    for (int ai = 0; ai < 2; ++ai)
#pragma unroll
        for (int m = 0; m < 4; ++m) { float s = (q[ai][m][0] + q[ai][m][1]) + (q[ai][m][2] + q[ai][m][3]); s += __shfl_xor(s, 16); s += __shfl_xor(s, 32); rs[ai][m] = 1.0f / sqrtf(s * (1.0f / 1024.0f) + 1e-5f); }
}
struct EpiGU {
    static constexpr bool PERM = true;
    bf16_t* hid; int ldh; const float* stats; mutable float rsv[2][4]; mutable int rs_pm;
    __device__ __forceinline__ void operator()(const f32x4 (&acc)[2][2][4][2], const Unit& u, int wr, int wc, int fr, int fq) const {
        if (u.pm != rs_pm) { rinv8_from_stats(stats, u.pm * BM + wr * 64 + fr, fq, rsv); rs_pm = u.pm; }
        const unsigned voff = ((unsigned)(wr * 64 + fr) * (unsigned)ldh + (unsigned)(wc * 32 + 8 * fq)) * 2u;
        char* hb = (char*)(hid + (size_t)u.pm * BM * ldh + u.pn * HALF);
#pragma unroll
        for (int ai = 0; ai < 2; ++ai)
#pragma unroll
            for (int m = 0; m < 4; ++m) { const float rs = rsv[ai][m], c1 = -1.4426950408889634f * rs, c3 = __builtin_amdgcn_rcpf(rs * rs);
                const f32x4 g0 = acc[ai][0][m][0], g1 = acc[ai][0][m][1], u0 = acc[ai][1][m][0], u1 = acc[ai][1][m][1];
                u32x4 r; r.x = cvt_pk_bf16(silu_mul_raw(g0[0], u0[0], c1, c3), silu_mul_raw(g0[1], u0[1], c1, c3)); r.y = cvt_pk_bf16(silu_mul_raw(g0[2], u0[2], c1, c3), silu_mul_raw(g0[3], u0[3], c1, c3));
                r.z = cvt_pk_bf16(silu_mul_raw(g1[0], u1[0], c1, c3), silu_mul_raw(g1[1], u1[1], c1, c3)); r.w = cvt_pk_bf16(silu_mul_raw(g1[2], u1[2], c1, c3), silu_mul_raw(g1[3], u1[3], c1, c3));
                *(u32x4*)(hb + (size_t)(ai * HALF + m * 16) * ldh * 2 + voff) = r; }
    }
};

struct EpiGU8 {
    static constexpr bool PERM = true;
    unsigned char* hid; int ldh;
    __device__ __forceinline__ void operator()(const f32x4 (&acc)[2][2][4][2], const Unit& u, int wr, int wc, int fr, int fq) const {
        const unsigned voff = (unsigned)(wr * 64 + fr) * (unsigned)ldh + (unsigned)(wc * 32 + 8 * fq);
        unsigned char* hb = hid + (size_t)u.pm * BM * ldh + u.pn * HALF;
        constexpr float c1 = -1.4426950408889634f / 2048.0f, c3 = 2048.0f * 2048.0f / 8.0f;
#pragma unroll
        for (int ai = 0; ai < 2; ++ai)
#pragma unroll
            for (int m = 0; m < 4; ++m) {
                const f32x4 g0 = acc[ai][0][m][0], g1 = acc[ai][0][m][1], u0 = acc[ai][1][m][0], u1 = acc[ai][1][m][1];
                uint2 p; p.x = pk4_fp8(silu_mul_raw(g0[0], u0[0], c1, c3), silu_mul_raw(g0[1], u0[1], c1, c3), silu_mul_raw(g0[2], u0[2], c1, c3), silu_mul_raw(g0[3], u0[3], c1, c3));
                p.y = pk4_fp8(silu_mul_raw(g1[0], u1[0], c1, c3), silu_mul_raw(g1[1], u1[1], c1, c3), silu_mul_raw(g1[2], u1[2], c1, c3), silu_mul_raw(g1[3], u1[3], c1, c3));
                *(uint2*)(hb + (size_t)(ai * HALF + m * 16) * ldh + voff) = p; }
    }
};
struct EpiQKV {
    static constexpr bool PERM = true;
    bf16_t* q; size_t tstride; const float* stats; float* nmax;
    __device__ __forceinline__ void operator()(const f32x4 (&acc)[2][2][4][2], const Unit& u, int wr, int wc, int fr, int fq) const {
        const int which = u.pn >> 2, ct = u.pn & 3; bf16_t* out = q + (size_t)which * tstride; float mx[2] = {0.f, 0.f};
        float rsv[2][4]; rinv8_from_stats(stats, u.pm * BM + wr * 64 + fr, fq, rsv);
#pragma unroll
        for (int ai = 0; ai < 2; ++ai)
#pragma unroll
            for (int m = 0; m < 4; ++m) { const int row = u.pm * BM + ai * HALF + wr * 64 + m * 16 + fr; const float rs = rsv[ai][m];
#pragma unroll
                for (int bj = 0; bj < 2; ++bj) { const f32x4 v0 = acc[ai][bj][m][0] * rs, v1 = acc[ai][bj][m][1] * rs;
                    u32x4 r; r.x = cvt_pk_bf16(v0[0], v0[1]); r.y = cvt_pk_bf16(v0[2], v0[3]); r.z = cvt_pk_bf16(v1[0], v1[1]); r.w = cvt_pk_bf16(v1[2], v1[3]);
                    *(u32x4*)(out + (size_t)row * 1024 + ct * BM + bj * HALF + wc * 32 + 8 * fq) = r;
                    if (which < 2) { float ss = ((v0[0] * v0[0] + v0[1] * v0[1]) + (v0[2] * v0[2] + v0[3] * v0[3])) + ((v1[0] * v1[0] + v1[1] * v1[1]) + (v1[2] * v1[2] + v1[3] * v1[3]));
                        ss += __shfl_xor(ss, 16); ss += __shfl_xor(ss, 32); mx[bj] = fmaxf(mx[bj], ss); } } }
        if (which < 2) {
#pragma unroll
            for (int bj = 0; bj < 2; ++bj) { float v = mx[bj]; v = fmaxf(v, __shfl_xor(v, 1)); v = fmaxf(v, __shfl_xor(v, 2)); v = fmaxf(v, __shfl_xor(v, 4)); v = fmaxf(v, __shfl_xor(v, 8));
                if (fr == 0 && fq == 0) nmax[(((size_t)which * 128 + u.pm) * 16 + ct * 4 + bj * 2 + (wc >> 1)) * 4 + 2 * (wc & 1) + wr] = v; }
        }
    }
};

struct EpiMoeD {
    static constexpr bool PERM = true;
    bf16_t* y; const int2* slotinfo; float scale;
    __device__ __forceinline__ void operator()(const f32x4 (&acc)[2][2][4][2], const Unit& u, int wr, int wc, int fr, int fq) const {
        int fr_ = fr; asm volatile("" : "+v"(fr_), "+v"(fq));
        int2 siv[2][4];
#pragma unroll
        for (int ai = 0; ai < 2; ++ai)
#pragma unroll
            for (int m = 0; m < 4; ++m) siv[ai][m] = slotinfo[u.pm * BM + ai * HALF + wr * 64 + m * 16 + fr_];
#pragma unroll
        for (int ai = 0; ai < 2; ++ai)
#pragma unroll
            for (int m = 0; m < 4; ++m) { const int2 si = siv[ai][m];
                if (si.x >= 0) { const float w = __int_as_float(si.y) * scale;
#pragma unroll
                    for (int bj = 0; bj < 2; ++bj) { const size_t o = (size_t)si.x * 1024 + u.pn * BM + bj * HALF + wc * 32 + 8 * fq; const f32x4 v0 = acc[ai][bj][m][0] * w, v1 = acc[ai][bj][m][1] * w;
                        u32x4 r; r.x = cvt_pk_bf16(v0[0], v0[1]); r.y = cvt_pk_bf16(v0[2], v0[3]); r.z = cvt_pk_bf16(v1[0], v1[1]); r.w = cvt_pk_bf16(v1[2], v1[3]);
                        *(u32x4*)(y + o) = r; } } }
    }
};

typedef int v4i_t __attribute__((ext_vector_type(4)));
typedef int v8i_t __attribute__((ext_vector_type(8)));
__device__ __forceinline__ void glds16_sv(const void* sbase, unsigned voff, unsigned lds_dst) { unsigned keep;
    asm volatile("s_mov_b32 %0, m0\n\ts_mov_b32 m0, %3\n\ts_nop 0\n\tglobal_load_lds_dwordx4 %1, %2\n\ts_mov_b32 m0, %0" : "=&s"(keep) : "v"(voff), "s"(sbase), "s"(lds_dst) : "memory"); }
template <class Epi, class Sched, bool ALIGN_EPI, int ESZ = 2, bool PEEL_A = true, bool PEEL_B = true>
__device__ __forceinline__ void gemm_phase(PG8_LAS unsigned char* lds, const Gemm g, const Sched& S, const Epi& E) {
    const int wid = __builtin_amdgcn_readfirstlane((int)threadIdx.x >> 6); int lane = lane_id(); asm volatile("" : "+v"(lane));
    const int tid = wid * 64 + lane; const int wr = wid >> 2, wc = wid & 3, fr = lane & 15, fq = lane >> 4;
    const int K = g.K, nt = K * ESZ / (BK * 2);
    const unsigned lda2 = (unsigned)g.lda * (unsigned)ESZ, ldb2 = (unsigned)g.ldb * (unsigned)ESZ;
    unsigned voffB[2], CA[2]; int RA[2];
#pragma unroll
    for (int i = 0; i < 2; ++i) { int R, C; stage_rc(tid * 16 + i * 8192, R, C); const int Rb = Epi::PERM ? ((R & ~31) + perm32(R & 31)) : R;
        RA[i] = R; CA[i] = (unsigned)C * 2u; voffB[i] = (unsigned)Rb * ldb2 + (unsigned)C * 2u; }
    const size_t kstep = (size_t)(BK * 2);
    const size_t hstepB = (size_t)HALF * ldb2;
    const unsigned ldsw = (unsigned)wid * 1024u;
    const int aoff = lds_byte(wr * 64 + fr, fq * 8), boff = lds_byte(wc * 32 + fr, fq * 8);
    const PG8_LAS unsigned char* abase = lds + aoff; const PG8_LAS unsigned char* bbase = lds + 4 * HTB + boff; asm volatile("" : "+v"(abase), "+v"(bbase));
    const unsigned ldsbase = (unsigned)__builtin_amdgcn_readfirstlane((int)((unsigned)(size_t)lds + ldsw));
#define PG8_OFFS(o, u) do { _Pragma("unroll") for (int _h = 0; _h < 2; ++_h) _Pragma("unroll") for (int _i = 0; _i < 2; ++_i) \
        (o)[_h][_i] = (Sched::GATHER ? (unsigned)S.tok((u).pm * BM + _h * HALF + RA[_i]) : (unsigned)(_h * HALF + RA[_i])) * lda2 + CA[_i]; } while (0)
#define PG8_SA(b, h) (((b) * 2 + (h)) * HTB)
#define PG8_SB(b, h) ((4 + (b) * 2 + (h)) * HTB)
#define PG8_STAGE(bufoff, gbase, voff) do { _Pragma("unroll") for (int _i = 0; _i < 2; ++_i) \
        glds16_sv((const char*)(gbase), (voff)[_i], ldsbase + (unsigned)((bufoff) + _i * 8192)); } while (0)
#define PG8_LD32(base, off) __builtin_shufflevector(*(const PG8_LAS v4i_t*)((base) + (off)), *(const PG8_LAS v4i_t*)((base) + (off) + 1024), 0, 1, 2, 3, 4, 5, 6, 7)
#define PG8_LDA(dst, b, h) do { if constexpr (ESZ == 2) { _Pragma("unroll") for (int m = 0; m < 4; ++m) _Pragma("unroll") for (int k = 0; k < 2; ++k) dst[m][k] = *(const PG8_LAS bf16x8*)(abase + PG8_SA(b, h) + m * 2048 + k * 1024); } \
      else { _Pragma("unroll") for (int m = 0; m < 4; ++m) dst##8[m] = PG8_LD32(abase, PG8_SA(b, h) + m * 2048); } } while (0)
#define PG8_LDB(dst, b, h) do { if constexpr (ESZ == 2) { _Pragma("unroll") for (int n = 0; n < 2; ++n) _Pragma("unroll") for (int k = 0; k < 2; ++k) dst[n][k] = *(const PG8_LAS bf16x8*)(bbase + (PG8_SB(b, h) - 4 * HTB) + n * 2048 + k * 1024); } \
      else { _Pragma("unroll") for (int n = 0; n < 2; ++n) dst##8[n] = PG8_LD32(bbase, (PG8_SB(b, h) - 4 * HTB) + n * 2048); } } while (0)
#define PG8_CAT(x, y) __builtin_shufflevector(__builtin_bit_cast(v4i_t, x), __builtin_bit_cast(v4i_t, y), 0, 1, 2, 3, 4, 5, 6, 7)
#define PG8_MMA(ai, bj, At, Bt, Z) do { __builtin_amdgcn_s_setprio(1); if constexpr (ESZ == 2) { _Pragma("unroll") for (int m = 0; m < 4; ++m) _Pragma("unroll") for (int n = 0; n < 2; ++n) _Pragma("unroll") for (int k = 0; k < 2; ++k) \
        acc[ai][bj][m][n] = __builtin_amdgcn_mfma_f32_16x16x32_bf16(Bt[n][k], At[m][k], ((Z) && k == 0) ? (f32x4){0.f, 0.f, 0.f, 0.f} : acc[ai][bj][m][n], 0, 0, 0); } \
      else { _Pragma("unroll") for (int m = 0; m < 4; ++m) _Pragma("unroll") for (int n = 0; n < 2; ++n) \
        acc[ai][bj][m][n] = __builtin_amdgcn_mfma_scale_f32_16x16x128_f8f6f4(Bt##8[n], At##8[m], (Z) ? (f32x4){0.f, 0.f, 0.f, 0.f} : acc[ai][bj][m][n], 0, 0, 0, 0x7f7f7f7f, 0, 0x7f7f7f7f); } \
      __builtin_amdgcn_s_setprio(0); } while (0)
#define PG8_WAIT_V(n) asm volatile("s_waitcnt vmcnt(" #n ")" ::: "memory")
#define PG8_WAIT_L(n) asm volatile("s_waitcnt lgkmcnt(" #n ")" ::: "memory")
#define PG8_BAR __builtin_amdgcn_s_barrier()
#define PG8_SCHED __builtin_amdgcn_sched_barrier(0)
    Unit cur, nxt; int ui = 0;
    if (!S.next(0, cur)) return;
    f32x4 acc[2][2][4][2];
    bf16x8 At[4][2], B0[2][2], B1[2][2]; v8i_t At8[4], B08[2], B18[2];
    unsigned offc[2][2];
    PG8_LAS u32x4* stash = (PG8_LAS u32x4*)(lds + STAGE_BYTES) + tid;
    PG8_OFFS(offc, cur);
    const char* cA = (const char*)g.A + cur.aoff; const char* cB = (const char*)g.Bt + cur.boff;
    PG8_STAGE(PG8_SB(0, 0), cB, voffB); PG8_STAGE(PG8_SB(0, 1), cB + hstepB, voffB); PG8_STAGE(PG8_SA(0, 0), cA, offc[0]); PG8_STAGE(PG8_SA(0, 1), cA, offc[1]);
    if (wr == 1) PG8_BAR;
    PG8_WAIT_V(2); PG8_BAR;
    PG8_STAGE(PG8_SB(1, 0), cB + kstep, voffB); PG8_STAGE(PG8_SA(1, 0), cA + kstep, offc[0]); PG8_STAGE(PG8_SB(1, 1), cB + hstepB + kstep, voffB);
    PG8_WAIT_V(6); PG8_BAR;
    for (;;) {
        const bool has_next = S.next(ui + 1, nxt);
        if constexpr (Sched::GATHER) { if (has_next) { unsigned t_[2][2]; PG8_OFFS(t_, nxt); *stash = (u32x4){t_[0][0], t_[0][1], t_[1][0], t_[1][1]}; } }
        const char* nA = has_next ? (const char*)g.A + nxt.aoff : cA; const char* nB = has_next ? (const char*)g.Bt + nxt.boff : cB;
#define PG8_KBODY(ZF, ZG) do { \
            const bool last = ((ZF) || (ZG)) ? false : (t == nt - 2); \
            const char* a1 = cA + (size_t)(t + 1) * kstep; \
            const char* a2 = last ? nA : cA + (size_t)(t + 2) * kstep; const char* b2 = last ? nB : cB + (size_t)(t + 2) * kstep; \
            const char* a3 = a2 + kstep; const char* b3 = b2 + kstep; \
            unsigned o2[2][2]; \
_Pragma("unroll") \
            for (int h = 0; h < 2; ++h) \
_Pragma("unroll") \
                for (int i = 0; i < 2; ++i) o2[h][i] = offc[h][i]; \
            if constexpr (Sched::GATHER) { if (last && has_next) { const u32x4 s_ = *stash; o2[0][0] = s_[0]; o2[0][1] = s_[1]; o2[1][0] = s_[2]; o2[1][1] = s_[3]; } } \
 \
 \
            PG8_LDB(B0, 0, 0); PG8_LDB(B1, 0, 1); PG8_SCHED; PG8_LDA(At, 0, 0); PG8_STAGE(PG8_SA(1, 1), a1, offc[1]); \
            PG8_WAIT_V(8); PG8_WAIT_L(0); PG8_BAR; PG8_SCHED; PG8_MMA(0, 0, At, B0, ZF); PG8_MMA(0, 1, At, B1, ZF); PG8_SCHED; PG8_BAR; PG8_SCHED; \
 \
            PG8_LDA(At, 0, 1); PG8_STAGE(PG8_SB(0, 0), b2, voffB); PG8_STAGE(PG8_SB(0, 1), b2 + hstepB, voffB); PG8_STAGE(PG8_SA(0, 0), a2, o2[0]); \
            PG8_WAIT_V(8); PG8_WAIT_L(0); PG8_BAR; PG8_SCHED; PG8_MMA(1, 0, At, B0, ZG); PG8_MMA(1, 1, At, B1, ZG); PG8_SCHED; PG8_BAR; PG8_SCHED; \
 \
            PG8_LDB(B0, 1, 0); PG8_LDB(B1, 1, 1); PG8_SCHED; PG8_LDA(At, 1, 0); PG8_STAGE(PG8_SA(0, 1), a2, o2[1]); \
            PG8_WAIT_V(8); PG8_WAIT_L(0); PG8_BAR; PG8_SCHED; PG8_MMA(0, 0, At, B0, false); PG8_MMA(0, 1, At, B1, false); PG8_SCHED; PG8_BAR; PG8_SCHED; \
 \
            PG8_LDA(At, 1, 1); PG8_STAGE(PG8_SB(1, 0), b3, voffB); PG8_STAGE(PG8_SB(1, 1), b3 + hstepB, voffB); PG8_STAGE(PG8_SA(1, 0), a3, o2[0]); \
            PG8_WAIT_V(8); PG8_WAIT_L(0); PG8_BAR; PG8_SCHED; PG8_MMA(1, 0, At, B0, false); PG8_MMA(1, 1, At, B1, false); PG8_SCHED; PG8_BAR; PG8_SCHED; \
        } while (0)
        constexpr bool ZA = PEEL_A, ZB = PEEL_B;
#define PG8_ZERO4(x) do { f32x2 lo_, hi_; asm volatile("v_mov_b64 %0, 0" : "=v"(lo_)); asm volatile("v_mov_b64 %0, 0" : "=v"(hi_)); (x) = (f32x4){lo_[0], lo_[1], hi_[0], hi_[1]}; } while (0)
        if constexpr (!ZA) {
#pragma unroll
            for (int b = 0; b < 2; ++b)
#pragma unroll
                for (int m = 0; m < 4; ++m)
#pragma unroll
                    for (int n = 0; n < 2; ++n) PG8_ZERO4(acc[0][b][m][n]); }
        if constexpr (!ZB) {
#pragma unroll
            for (int b = 0; b < 2; ++b)
#pragma unroll
                for (int m = 0; m < 4; ++m)
#pragma unroll
                    for (int n = 0; n < 2; ++n) PG8_ZERO4(acc[1][b][m][n]); }
#undef PG8_ZERO4
        if constexpr (ZA || ZB) { const int t = 0; PG8_KBODY(ZA, ZB); }
#pragma nounroll
        for (int t = (ZA || ZB) ? 2 : 0; t < nt; t += 2) { PG8_KBODY(false, false); }
#undef PG8_KBODY
        if constexpr (ALIGN_EPI) { if (wr == 0) PG8_BAR; }
        E(acc, cur, wr, wc, fr, fq);
        if (!has_next) break;
        cur = nxt; cA = nA; cB = nB; ++ui;
        if constexpr (Sched::GATHER) { const u32x4 s_ = *stash; offc[0][0] = s_[0]; offc[0][1] = s_[1]; offc[1][0] = s_[2]; offc[1][1] = s_[3]; }
        if constexpr (ALIGN_EPI) { if (wr == 1) PG8_BAR; }
    }
    PG8_WAIT_V(0);
    if constexpr (!ALIGN_EPI) { if (wr == 0) PG8_BAR; }
    PG8_BAR;
#undef PG8_OFFS
#undef PG8_SA
#undef PG8_SB
#undef PG8_STAGE
#undef PG8_LDA
#undef PG8_LD32
#undef PG8_LDB
#undef PG8_MMA
#undef PG8_CAT
#undef PG8_WAIT_V
#undef PG8_WAIT_L
#undef PG8_BAR
#undef PG8_SCHED
}
}
constexpr int CONV_ITEMS_PER_UNIT = 48, N_CONV_ALL = (NE * (2 * 16 * (FFE / 64) + (FFE / 64) * 16)) / CONV_ITEMS_PER_UNIT;
constexpr int CONV_P4 = 128, N_CONV_UNITS = N_CONV_ALL - CONV_P4;
__device__ __forceinline__ void expert_conv_unit(unsigned char* ws, int cu, __attribute__((address_space(3))) unsigned char* lds);
#include <hip/hip_bf16.h>
#include <cmath>
namespace attn_body {
using bf16=__hip_bfloat16;
using bf16x8=__attribute__((ext_vector_type(8)))short;
using s16x4=__attribute__((ext_vector_type(4)))short;
using f32x16=__attribute__((ext_vector_type(16)))float;
using u32x4=__attribute__((ext_vector_type(4)))unsigned;
constexpr int BATCH=2,NHEAD=16,SEQ=16384,D=64,DM=NHEAD*D;
constexpr int NW=8,QBLK=32,QB=QBLK*NW,KVBLK=64,NQB=SEQ/QB;
constexpr int ATTN_PITCH=DM, ATTN_UNIT_ROWS=QB;
__device__ __forceinline__ int crow(int r,int hi){return (r&3)+8*(r>>2)+4*hi;}
#define SBAR() __builtin_amdgcn_sched_barrier(0)
__device__ __forceinline__ void cmask(f32x16&p0,f32x16&p1,int jb,int qrel,int hi){
  const float NEG=-INFINITY; int kb=64*jb+4*hi;
  #pragma unroll
  for(int r=0;r<16;++r){int kv=kb+(r&3)+8*(r>>2); if(kv>qrel)p0[r]=NEG; if(kv+32>qrel)p1[r]=NEG;}
}

constexpr int NSLOT=3, SLOTB=8192;
constexpr int LDS_K=0, LDS_V=NSLOT*SLOTB, LDS_WS=2*NSLOT*SLOTB, LDS_OST=LDS_WS+NW*64*4, LDS_BYTES=LDS_OST+NW*4096;
constexpr float C2=0.125f*1.4426950408889634f;
__device__ __forceinline__ void glds16s(const void*sbase,unsigned voff,unsigned lds_dst){unsigned keep;
  asm volatile("s_mov_b32 %0, m0\n\ts_mov_b32 m0, %3\n\ts_nop 0\n\tglobal_load_lds_dwordx4 %1, %2\n\ts_mov_b32 m0, %0":"=&s"(keep):"v"(voff),"s"(sbase),"s"(lds_dst):"memory");}
__device__ __forceinline__ void glds16(const void*gsrc,unsigned lds_dst){unsigned keep;
  asm volatile("s_mov_b32 %0, m0\n\ts_mov_b32 m0, %2\n\ts_nop 0\n\tglobal_load_lds_dwordx4 %1, off\n\ts_mov_b32 m0, %0":"=&s"(keep):"v"(gsrc),"s"(lds_dst):"memory");}
__device__ __forceinline__ float max3f(float a,float b,float c){float r;asm("v_max3_f32 %0, %1, %2, %3":"=v"(r):"v"(a),"v"(b),"v"(c));return r;}
__device__ __forceinline__ float max2f(float a,float b){float r;asm("v_max_f32_e32 %0, %1, %2":"=v"(r):"v"(a),"v"(b));return r;}
__device__ __forceinline__ float fadd_s(float a,float b){float r;asm("v_add_f32_e32 %0, %1, %2":"=v"(r):"v"(a),"v"(b));return r;}
__device__ __forceinline__ float fsub_s(float a,float b){float r;asm("v_sub_f32_e32 %0, %1, %2":"=v"(r):"v"(a),"v"(b));return r;}
typedef float f32x2_t __attribute__((ext_vector_type(2))); typedef __bf16 bf16x2_t __attribute__((ext_vector_type(2)));
__device__ __forceinline__ unsigned cvtpk_s(float lo,float hi){f32x2_t v={lo,hi};bf16x2_t b=__builtin_convertvector(v,bf16x2_t);return __builtin_bit_cast(unsigned,b);}
#define WAIT_BAR(N) asm volatile("s_waitcnt vmcnt(" #N ") lgkmcnt(0)\n\ts_barrier":::"memory")

__device__ __forceinline__ void qkt(f32x16&p0,f32x16&p1,const char*Kslot,const bf16x8*qr,bf16x8 kxa,bf16x8 kxb,bf16x8 qx,int r32,int hi){
  p0=__builtin_amdgcn_mfma_f32_32x32x16_bf16(kxa,qx,f32x16{},0,0,0);p1=__builtin_amdgcn_mfma_f32_32x32x16_bf16(kxb,qx,f32x16{},0,0,0);
  const char*kb=Kslot+hi*1024+r32*16;
  #pragma unroll
  for(int d0=0;d0<4;++d0){
    const bf16x8 b0=*reinterpret_cast<const bf16x8*>(kb+d0*2048);
    const bf16x8 b1=*reinterpret_cast<const bf16x8*>(kb+d0*2048+512);
    p0=__builtin_amdgcn_mfma_f32_32x32x16_bf16(b0,qr[d0],p0,0,0,0);p1=__builtin_amdgcn_mfma_f32_32x32x16_bf16(b1,qr[d0],p1,0,0,0);}
}
typedef __attribute__((address_space(3))) const char* lds_cptr;
typedef short v4i16_t __attribute__((ext_vector_type(4)));
__device__ __forceinline__ void kload8(bf16x8*kf,lds_cptr kp){
  kf[0]=*(const __attribute__((address_space(3))) bf16x8*)(kp);      kf[1]=*(const __attribute__((address_space(3))) bf16x8*)(kp+512);
  kf[2]=*(const __attribute__((address_space(3))) bf16x8*)(kp+2048); kf[3]=*(const __attribute__((address_space(3))) bf16x8*)(kp+2560);
  kf[4]=*(const __attribute__((address_space(3))) bf16x8*)(kp+4096); kf[5]=*(const __attribute__((address_space(3))) bf16x8*)(kp+4608);
  kf[6]=*(const __attribute__((address_space(3))) bf16x8*)(kp+6144); kf[7]=*(const __attribute__((address_space(3))) bf16x8*)(kp+6656);
}
__device__ __forceinline__ void kload2(bf16x8*kf,lds_cptr kp,int j){ kf[2*j]=*(const __attribute__((address_space(3))) bf16x8*)(kp+j*2048); kf[2*j+1]=*(const __attribute__((address_space(3))) bf16x8*)(kp+j*2048+512); }
__device__ __forceinline__ s16x4 vtr(lds_cptr p){ return __builtin_bit_cast(s16x4,__builtin_amdgcn_ds_read_tr16_b64_v4i16((__attribute__((address_space(3))) v4i16_t*)p)); }
__device__ __forceinline__ float rowmax(const f32x16&p0,const f32x16&p1){
  float a=max3f(p0[0],p0[1],p1[0]),b=max3f(p0[2],p0[3],p1[1]);a=max3f(a,p1[2],p1[3]);
  #pragma unroll
  for(int r=4;r<16;r+=4){a=max3f(a,p0[r],p0[r+1]);b=max3f(b,p0[r+2],p0[r+3]);a=max3f(a,p1[r],p1[r+1]);b=max3f(b,p1[r+2],p1[r+3]);}
  const float m=max2f(a,b);
  auto rr=__builtin_amdgcn_permlane32_swap(__float_as_uint(m),__float_as_uint(m),false,false);
  return max2f(__uint_as_float(rr[0]),__uint_as_float(rr[1]));
}
__device__ __forceinline__ void pv(f32x16*o,int vb,bf16x8 pa0,bf16x8 pa1,bf16x8 pa2,bf16x8 pa3){
  #pragma unroll
  for(int d0=0;d0<2;++d0){s16x4 lo[4],hi[4];
    #pragma unroll
    for(int ks=0;ks<4;++ks){
      asm volatile("ds_read_b64_tr_b16 %0,%1 offset:%c2":"=&v"(lo[ks]):"v"(vb),"i"(d0*4096+ks*1024):"memory");
      asm volatile("ds_read_b64_tr_b16 %0,%1 offset:%c2":"=&v"(hi[ks]):"v"(vb),"i"(d0*4096+ks*1024+512):"memory");}
    asm volatile("s_waitcnt lgkmcnt(0)":::"memory");SBAR();
    #define PK(k) (bf16x8){lo[k][0],lo[k][1],lo[k][2],lo[k][3],hi[k][0],hi[k][1],hi[k][2],hi[k][3]}
    o[d0]=__builtin_amdgcn_mfma_f32_32x32x16_bf16(pa0,PK(0),o[d0],0,0,0);
    o[d0]=__builtin_amdgcn_mfma_f32_32x32x16_bf16(pa1,PK(1),o[d0],0,0,0);
    o[d0]=__builtin_amdgcn_mfma_f32_32x32x16_bf16(pa2,PK(2),o[d0],0,0,0);
    o[d0]=__builtin_amdgcn_mfma_f32_32x32x16_bf16(pa3,PK(3),o[d0],0,0,0);
    #undef PK
  }
}

__device__ __forceinline__ void split3(float g,unsigned&h,unsigned&m,unsigned&l){ h=__float_as_uint(g)&0xffff0000u; const float r1=g-__uint_as_float(h); m=__float_as_uint(r1)&0xffff0000u; const float r2=r1-__uint_as_float(m); l=__float_as_uint(r2)&0xffff0000u; }
__device__ __forceinline__ float rndbf(float x){ const unsigned u=__float_as_uint(x); return __uint_as_float((u+0x7fffu+((u>>16)&1u))&0xffff0000u); }
typedef __attribute__((address_space(3))) const float* lds_fptr;
#ifndef ATTN_STORE16
#define ATTN_STORE16(p,v) (*(u32x4*)(p)=(v))
#endif
template<int THRL> __device__ __forceinline__ void attn_unit(int b,int h,int qb,int t0,const bf16*Q,const bf16*__restrict__ K,const bf16*__restrict__ V,bf16*O,char*shm,lds_fptr gwp,lds_fptr offs){
  int tid=threadIdx.x; asm volatile("":"+v"(tid)); const int lane=tid&63,r32=lane&31,hi=lane>>5; const int wid=__builtin_amdgcn_readfirstlane(tid>>6);
  const long rowbase=(long)b*SEQ; const int q0=qb*QB;
  const bf16*Qw=Q+(rowbase+q0+wid*QBLK)*DM+h*D;
  const bf16*Kh=K+(rowbase+(long)t0*KVBLK)*DM+h*D,*Vh=V+(rowbase+(long)t0*KVBLK)*DM+h*D;
  const unsigned lds0=(unsigned)(uintptr_t)shm;
  float*wsf=(float*)(shm+LDS_WS)+wid*64;
  const unsigned koff=(unsigned)(lane*DM+wid*8)*2u;
  const unsigned voff=(unsigned)((16*(wid&3)+(lane>>2))*DM+(wid>>2)*32+(lane&3)*8)*2u;
  const unsigned kdst=lds0+LDS_K+wid*1024, vdst=lds0+LDS_V+wid*1024;
  #define DMA_K(t,slot) glds16s(Kh+(long)(t)*KVBLK*DM,koff,(unsigned)__builtin_amdgcn_readfirstlane(kdst+(slot)))
  #define DMA_V(t,slot) glds16s(Vh+(long)(t)*KVBLK*DM,voff,(unsigned)__builtin_amdgcn_readfirstlane(vdst+(slot)))
  const int vb0=(int)(lds0+LDS_V)+((lane>>4)&1)*32+(lane&3)*8+(4*hi+((lane&15)>>2))*64;
  const char*Kbase=shm+LDS_K; bf16x8 kf[8];
  const lds_cptr shm3=(lds_cptr)shm; const lds_cptr kp0=shm3+LDS_K+hi*1024+r32*16; const lds_cptr vp0=shm3+LDS_V+((lane>>4)&1)*32+(lane&3)*8+(4*hi+((lane&15)>>2))*64;
  const int NT=(q0+QB)/KVBLK-t0;
  DMA_K(0,0);DMA_V(0,0);DMA_K(1,SLOTB);
  bf16x8 qr[4];
  #pragma unroll
  for(int d0=0;d0<4;++d0)qr[d0]=*reinterpret_cast<const bf16x8*>(&Qw[(long)r32*DM+d0*16+hi*8]);
  const lds_cptr qst=shm3+LDS_OST+wid*4096+lane*16;
  *(__attribute__((address_space(3))) bf16x8*)(qst)=qr[2]; *(__attribute__((address_space(3))) bf16x8*)(qst+1024)=qr[3];
  #define QLD(j) (*(const __attribute__((address_space(3))) bf16x8*)(qst+((j)-2)*1024))
  float mhat=0.f,l_reg=0.f;f32x16 o[2];o[0]=f32x16{};o[1]=f32x16{};
  #define HM(x) (hi?0u:(x))
  u32x4 kxa,kxb,qxv; kxa[0]=HM(0x3F803F80u);kxa[3]=HM(0x00003F80u);kxb[0]=kxa[0];kxb[3]=kxa[3];
  float ga_,gb_;
  #define KXLOAD(T) do{ const float o_=offs[(T)]; ga_=gwp[(T)*KVBLK+r32]+o_; gb_=gwp[(T)*KVBLK+32+r32]+o_; }while(0)
  #define KXMAKE() do{ unsigned h_,m_,l_; split3(ga_,h_,m_,l_); kxa[1]=HM(0x3F80u|(h_^0x80000000u)); kxa[2]=HM(((m_^0x80000000u)>>16)|(l_^0x80000000u)); \
      split3(gb_,h_,m_,l_); kxb[1]=HM(0x3F80u|(h_^0x80000000u)); kxb[2]=HM(((m_^0x80000000u)>>16)|(l_^0x80000000u)); }while(0)
  #define KXA __builtin_bit_cast(bf16x8,kxa)
  #define KXB __builtin_bit_cast(bf16x8,kxb)
  #define QXV __builtin_bit_cast(bf16x8,qxv)
  const int qrel=wid*QBLK+r32;
  #define CMASK(P0,P1,t) do{int jb_=(t)-(NT-4); if(jb_>=0)cmask(P0,P1,jb_,qrel,hi);}while(0)
  bool resc=false;
  #define START(P0,P1) do{ const float rm=rowmax(P0,P1); resc=false; \
    { const float dl=rndbf(rm); mhat=dl; \
      _Pragma("unroll") for(int r=0;r<16;++r){P0[r]=fsub_s(P0[r],dl);P1[r]=fsub_s(P1[r],dl);} \
      qxv[3]=HM(__float_as_uint(-mhat)>>16); } \
    _Pragma("unroll") for(int r=0;r<16;++r)P0[r]=__builtin_amdgcn_exp2f(P0[r]); }while(0)
  #define RESC() do{ if(resc){ asm volatile("s_waitcnt lgkmcnt(0)":::"memory"); \
      _Pragma("unroll") for(int d_=0;d_<2;++d_) _Pragma("unroll") for(int r=0;r<16;++r)o[d_][r]*=wsf[crow(r,hi)]; } }while(0)
  f32x16 pA0,pA1,pB0,pB1;
  int sl_prev=0,sl_cur=0,sl_next=SLOTB;
  #define ROT() do{sl_prev=sl_cur;sl_cur=sl_next;sl_next=(sl_next==(NSLOT-1)*SLOTB)?0:sl_next+SLOTB;}while(0)
  DMA_K(2,2*SLOTB);
  WAIT_BAR(3);
  { unsigned h_,m_,l_; split3(gwp[q0-t0*KVBLK+wid*QBLK+r32]+offs[q0/KVBLK-t0+(wid>>1)],h_,m_,l_); qxv[0]=HM((h_>>16)|m_); qxv[1]=HM((l_>>16)|0x3F800000u); qxv[2]=kxa[0]; qxv[3]=0u; }
  KXLOAD(0); KXMAKE();
  qkt(pA0,pA1,Kbase,qr,KXA,KXB,QXV,r32,hi);asm volatile("s_nop 15\n\ts_nop 7":"+v"(pA0),"+v"(pA1));CMASK(pA0,pA1,0);
  START(pA0,pA1);
  _Pragma("unroll") for(int r=0;r<16;++r)pA1[r]=__builtin_amdgcn_exp2f(pA1[r]);
  KXLOAD(1); KXMAKE();
  WAIT_BAR(0);
  DMA_K(3,0);DMA_V(1,SLOTB);
  ROT();
  kload8(kf,kp0+sl_cur);
  WAIT_BAR(2);
  s16x4 vlo[8],vhi[8]; u32x4 pw0,pw1,pw2,pw3;
  #define PKW(P,B) cvtpk_s(P[B],P[B+1])
  #define PAF(k) __builtin_bit_cast(bf16x8,pw##k)
  #define VFR(i) (bf16x8){vlo[i][0],vlo[i][1],vlo[i][2],vlo[i][3],vhi[i][0],vhi[i][1],vhi[i][2],vhi[i][3]}
  #define PIN(x) asm volatile("":"+v"(x))
  #define MX3(a,b,c) __builtin_fmaxf(__builtin_fmaxf((a),(b)),(c))
  #define GAPA(MF,A0,A1,A2,A3,W0,W1,PW) do{ MF; sacc+=A0; sacc+=A1; sacc+=A2; sacc+=A3; PIN(sacc); W0; W1; PIN(PW); SBAR(); }while(0)
  #define EX(v) __builtin_amdgcn_exp2f(v)
  #define GAPB(MF,X,B) do{ MF; X[B]=EX(X[B]); X[B+1]=EX(X[B+1]); X[B+2]=EX(X[B+2]); X[B+3]=EX(X[B+3]); PIN(X); SBAR(); }while(0)
  #define VRD(i) do{ vlo[i]=vtr(vp_+(((i)>>2)*4096+((i)&3)*1024)); vhi[i]=vtr(vp_+(((i)>>2)*4096+((i)&3)*1024+512)); }while(0)
  #define KRD(G,j) do{ if(G){ kload2(kf,kp0+sl_next,j); SBAR(); } }while(0)
  #define STEP(C0,C1,P0,P1,t,GK,GV,GL) do{ SBAR(); \
    const lds_cptr vp_=vp0+sl_prev; \
    C0=__builtin_amdgcn_mfma_f32_32x32x16_bf16(KXA,QXV,f32x16{},0,0,0); C1=__builtin_amdgcn_mfma_f32_32x32x16_bf16(KXB,QXV,f32x16{},0,0,0); SBAR(); \
    VRD(0); SBAR(); float sacc=(P0[0]+P0[1]); \
    GAPA(C0=__builtin_amdgcn_mfma_f32_32x32x16_bf16(kf[0],qr[0],C0,0,0,0), P0[2],P0[3],P0[4],P0[5],     pw0[0]=PKW(P0,0), pw0[1]=PKW(P0,2), pw0); \
    VRD(4); SBAR(); GAPA(C1=__builtin_amdgcn_mfma_f32_32x32x16_bf16(kf[1],qr[0],C1,0,0,0), P0[6],P0[7],P0[8],P0[9],     pw0[2]=PKW(P0,4), pw0[3]=PKW(P0,6), pw0); \
    VRD(1); const bf16x8 q2_=QLD(2); SBAR(); GAPA(C0=__builtin_amdgcn_mfma_f32_32x32x16_bf16(kf[2],qr[1],C0,0,0,0),   P0[10],P0[11],P0[12],P0[13], pw1[0]=PKW(P0,8), pw1[1]=PKW(P0,10), pw1); \
    VRD(5); SBAR(); GAPA(C1=__builtin_amdgcn_mfma_f32_32x32x16_bf16(kf[3],qr[1],C1,0,0,0),   P0[14],P0[15],P1[0],P1[1],   pw1[2]=PKW(P0,12),pw1[3]=PKW(P0,14), pw1); \
    VRD(2); const bf16x8 q3_=QLD(3); SBAR(); GAPA(C0=__builtin_amdgcn_mfma_f32_32x32x16_bf16(kf[4],q2_,C0,0,0,0),   P1[2],P1[3],P1[4],P1[5],     pw2[0]=PKW(P1,0), pw2[1]=PKW(P1,2), pw2); \
    VRD(6); SBAR(); GAPA(C1=__builtin_amdgcn_mfma_f32_32x32x16_bf16(kf[5],q2_,C1,0,0,0),   P1[6],P1[7],P1[8],P1[9],     pw2[2]=PKW(P1,4), pw2[3]=PKW(P1,6), pw2); \
    VRD(3); SBAR(); GAPA(C0=__builtin_amdgcn_mfma_f32_32x32x16_bf16(kf[6],q3_,C0,0,0,0),   P1[10],P1[11],P1[12],P1[13], pw3[0]=PKW(P1,8), pw3[1]=PKW(P1,10), pw3); \
    VRD(7); SBAR(); GAPA(C1=__builtin_amdgcn_mfma_f32_32x32x16_bf16(kf[7],q3_,C1,0,0,0),   P1[14],P1[15],0.f,0.f,       pw3[2]=PKW(P1,12),pw3[3]=PKW(P1,14), pw3); \
    l_reg+=sacc; \
    if(GK){DMA_K((t)+3,sl_cur);} if(GV){DMA_V((t)+1,sl_next);} \
    CMASK(C0,C1,t); \
    { float a=MX3(C0[0],C0[1],C1[0]),b=MX3(C0[2],C0[3],C1[1]); a=MX3(a,C1[2],C1[3]); \
      _Pragma("unroll") for(int r=4;r<16;r+=4){a=MX3(a,C0[r],C0[r+1]);b=MX3(b,C0[r+2],C0[r+3]);a=MX3(a,C1[r],C1[r+1]);b=MX3(b,C1[r+2],C1[r+3]);} \
      float rm=__builtin_fmaxf(a,b); { auto rr=__builtin_amdgcn_permlane32_swap(__float_as_uint(rm),__float_as_uint(rm),false,false); rm=__builtin_fmaxf(__uint_as_float(rr[0]),__uint_as_float(rr[1])); } \
      resc=false; \
      if(__builtin_expect(__any(rm>(float)THRL),0)){ const float mn_=rndbf(mhat+__builtin_fmaxf(rm,0.f)); const float dl=mn_-mhat; mhat=mn_; \
        _Pragma("unroll") for(int r=0;r<16;++r){C0[r]-=dl;C1[r]-=dl;} \
        qxv[3]=HM(__float_as_uint(-mhat)>>16); \
        const float f=__builtin_amdgcn_exp2f(-dl); l_reg*=f; if(hi==0)wsf[r32]=f; resc=true; } } \
    SBAR(); \
    GAPB(o[0]=__builtin_amdgcn_mfma_f32_32x32x16_bf16(PAF(0),VFR(0),o[0],0,0,0), C0,0); \
    GAPB(o[1]=__builtin_amdgcn_mfma_f32_32x32x16_bf16(PAF(0),VFR(4),o[1],0,0,0), C0,4); \
    if(GL){ KXLOAD((t)+1); SBAR(); } \
    KRD(GL,0); GAPB(o[0]=__builtin_amdgcn_mfma_f32_32x32x16_bf16(PAF(1),VFR(1),o[0],0,0,0), C0,8); \
    KRD(GL,1); GAPB(o[1]=__builtin_amdgcn_mfma_f32_32x32x16_bf16(PAF(1),VFR(5),o[1],0,0,0), C0,12); \
    KRD(GL,2); GAPB(o[0]=__builtin_amdgcn_mfma_f32_32x32x16_bf16(PAF(2),VFR(2),o[0],0,0,0), C1,0); \
    KRD(GL,3); GAPB(o[1]=__builtin_amdgcn_mfma_f32_32x32x16_bf16(PAF(2),VFR(6),o[1],0,0,0), C1,4); \
    if(GL){ KXMAKE(); SBAR(); } \
    GAPB(o[0]=__builtin_amdgcn_mfma_f32_32x32x16_bf16(PAF(3),VFR(3),o[0],0,0,0), C1,8); \
    GAPB(o[1]=__builtin_amdgcn_mfma_f32_32x32x16_bf16(PAF(3),VFR(7),o[1],0,0,0), C1,12); \
    }while(0)
  int t=1;
  #undef CMASK
  #define CMASK(P0,P1,t) do{}while(0)
  for(;t+5<NT;t+=2){
    STEP(pB0,pB1,pA0,pA1,t,true,true,true);     WAIT_BAR(2); RESC(); ROT();
    STEP(pA0,pA1,pB0,pB1,t+1,true,true,true);   WAIT_BAR(2); RESC(); ROT();
  }
  #undef CMASK
  #define CMASK(P0,P1,t) do{int jb_=(t)-(NT-4); if(jb_>=0)cmask(P0,P1,jb_,qrel,hi);}while(0)
  #define ENDW(tt) do{ if((tt)+3<NT){WAIT_BAR(2);} else if((tt)+2<NT){WAIT_BAR(1);} else {WAIT_BAR(0);} }while(0)
  for(;t+1<NT;t+=2){
    STEP(pB0,pB1,pA0,pA1,t,(t+3<NT),(t+1<NT),(t+1<NT));       ENDW(t);   RESC(); ROT();
    STEP(pA0,pA1,pB0,pB1,t+1,(t+4<NT),(t+2<NT),(t+2<NT));     ENDW(t+1); RESC(); ROT();
  }
  STEP(pB0,pB1,pA0,pA1,NT-1,false,false,false); RESC();
  { float sacc=pB0[0]+pB0[1]; _Pragma("unroll") for(int r=2;r<16;++r)sacc+=pB0[r]; _Pragma("unroll") for(int r=0;r<16;++r)sacc+=pB1[r]; l_reg+=sacc;
    pw0=(u32x4){PKW(pB0,0),PKW(pB0,2),PKW(pB0,4),PKW(pB0,6)};pw1=(u32x4){PKW(pB0,8),PKW(pB0,10),PKW(pB0,12),PKW(pB0,14)};pw2=(u32x4){PKW(pB1,0),PKW(pB1,2),PKW(pB1,4),PKW(pB1,6)};pw3=(u32x4){PKW(pB1,8),PKW(pB1,10),PKW(pB1,12),PKW(pB1,14)};
    SBAR(); pv(o,vb0+sl_cur,PAF(0),PAF(1),PAF(2),PAF(3)); }
  #undef PKW
  #undef PAF
  #undef VFR
  #undef PIN
  #undef MX3
  #undef GAPA
  #undef GAPB
  #undef EX
  #undef VRD
  #undef KRD
  #undef STEP
  #undef ENDW
  {auto rr=__builtin_amdgcn_permlane32_swap(__float_as_uint(l_reg),__float_as_uint(l_reg),false,false);l_reg=__uint_as_float(rr[0])+__uint_as_float(rr[1]);}
  if(hi==0)wsf[32+r32]=l_reg;asm volatile("s_waitcnt lgkmcnt(0)":::"memory");
  float rli[16];
  #pragma unroll
  for(int r=0;r<16;++r)rli[r]=__builtin_amdgcn_rcpf(wsf[32+crow(r,hi)]);
  bf16*Ow=O+(rowbase+q0+wid*QBLK)*DM+h*D;
  { bf16*stg=(bf16*)(shm+LDS_OST)+wid*2048;
    #pragma unroll
    for(int r=0;r<16;++r){const int orow=crow(r,hi);
      #pragma unroll
      for(int d0=0;d0<2;++d0)stg[orow*64+d0*32+r32]=__float2bfloat16(o[d0][r]*rli[r]);}
    asm volatile("s_waitcnt lgkmcnt(0)":::"memory");
    #pragma unroll
    for(int i=0;i<4;++i){const int row=i*8+(lane>>3),ch=lane&7; const u32x4 v=*(const u32x4*)(stg+row*64+ch*8); ATTN_STORE16(Ow+(long)row*DM+ch*8,v);} }
  asm volatile("s_waitcnt lgkmcnt(0)\n\ts_barrier":::"memory");
  #undef DMA_K
  #undef KXLOAD
  #undef QLD
  #undef HM
  #undef KXMAKE
  #undef KXA
  #undef KXB
  #undef QXV
  #undef DMA_V
  #undef CMASK
  #undef START
  #undef RESC
  #undef ROT
}
constexpr int ATTN_LDS_BYTES=LDS_BYTES;
template<int THRL=8> __device__ __forceinline__ void attn_phase(unsigned char*ws,char*lds,int gw_off,int p_off,int tbl_off,int offs_off,const bf16*Q,const bf16*K,const bf16*V,bf16*O,const float*fl,const float*ftot,const float*nmax,unsigned*qhead){
  typedef __attribute__((address_space(3))) float* lds_fw; typedef __attribute__((address_space(3))) int* lds_iw;
  const lds_fw gw=(lds_fw)(lds+gw_off); const lds_fw amax=(lds_fw)(lds+p_off+256); const lds_iw ctl=(lds_iw)(lds+p_off+512); const lds_fw tbl=(lds_fw)(lds+tbl_off); const lds_fw offs=(lds_fw)(lds+offs_off);
  const int tid=threadIdx.x,lane=tid&63; const int wid=__builtin_amdgcn_readfirstlane(tid>>6);
  for(int bh=wid;bh<BATCH*NHEAD;bh+=NW){ const float ft=ftot[((size_t)(bh>>4)*NQB+lane)*NHEAD+(bh&15)]; float inc=ft;
    #pragma unroll
    for(int o_=1;o_<64;o_<<=1){ const float t_=__shfl_up(inc,o_,64); if(lane>=o_)inc+=t_; }
    tbl[bh*NQB+lane]=inc-ft; }
  if(tid==0) ctl[3]=(int)blockIdx.x;
  __syncthreads();
  for(;;){
    int tid=threadIdx.x; asm volatile("":"+v"(tid)); const int lane=tid&63;
    const int qp=ctl[3]; if(qp>=BATCH*NHEAD*NQB+N_CONV_UNITS) break;
    unsigned nextq=0u; if(tid==0) nextq=__hip_atomic_fetch_add(qhead,1u,__ATOMIC_RELAXED,__HIP_MEMORY_SCOPE_AGENT)+gridDim.x;
    if(qp%5==4&&qp/5<N_CONV_UNITS){ ::expert_conv_unit(ws,qp/5,(__attribute__((address_space(3))) unsigned char*)lds); }
    else {
    const int ui=qp-(qp/5<N_CONV_UNITS?qp/5:N_CONV_UNITS);
    const int b=ui&1, rr_=ui>>1, qb=NQB-1-(rr_&(NQB-1)), h=NHEAD-1-(rr_>>6);
    const float*flh=fl+((size_t)b*NHEAD+h)*SEQ; const lds_fw pexu=tbl+(b*NHEAD+h)*NQB;
    float kn=0.f,qn=0.f,g4a=0.f,g4b=0.f,g4c=0.f,g4d=0.f;
    if(wid==0){
      const float4 kq=*(const float4*)(nmax+(((size_t)128+b*NQB+lane)*NHEAD+h)*4), qq=*(const float4*)(nmax+(((size_t)b*NQB+qb)*NHEAD+h)*4);
      if(lane<=qb){ const float*gp=flh+lane*QB+KVBLK-1; g4a=gp[0]; g4b=gp[KVBLK]; g4c=gp[2*KVBLK]; g4d=gp[3*KVBLK]; }
      kn=sqrtf(fmaxf(kq.x,kq.y)+fmaxf(kq.z,kq.w))*1.01f; qn=sqrtf(fmaxf(qq.x,qq.y)+fmaxf(qq.z,qq.w))*1.01f;
    }
    { const int r=tid>>1,hf=tid&1; const size_t ro=((size_t)b*SEQ+qb*QB+r)*DM+h*D+hf*32;
      const u32x4*qv=reinterpret_cast<const u32x4*>(Q+ro); const u32x4*kv=reinterpret_cast<const u32x4*>(K+ro); u32x4 qa[4],ka[4];
      #pragma unroll
      for(int j=0;j<4;++j){ qa[j]=qv[j]; ka[j]=kv[j]; }
      float d=0.f;
      #pragma unroll
      for(int j=0;j<4;++j)
        #pragma unroll
        for(int e=0;e<4;++e){ d+=__uint_as_float(qa[j][e]<<16)*__uint_as_float(ka[j][e]<<16)+__uint_as_float(qa[j][e]&0xffff0000u)*__uint_as_float(ka[j][e]&0xffff0000u); }
      d+=__shfl_xor(d,1,64);
      float a=flh[qb*QB+r]+pexu[qb]-d;
      #pragma unroll
      for(int o_=2;o_<64;o_<<=1) a=fmaxf(a,__shfl_xor(a,o_,64));
      if(lane==0) amax[wid]=a; }
    __syncthreads();
    if(wid==0){
      float A=amax[lane&7];
      #pragma unroll
      for(int o_=1;o_<8;o_<<=1) A=fmaxf(A,__shfl_xor(A,o_,64));
      const float inc=pexu[lane<NQB-1?lane+1:NQB-1];
      const bool skip=(lane<qb)&&(qn*kn+A+0.02f-inc<-70.0f);
      const unsigned long long mk=__ballot(skip); int ns=(~mk)==0ull?64:__builtin_ctzll(~mk); if(ns>qb)ns=qb;
      int nt2=0;
      if(ns<qb){ const float knb=__shfl(kn,ns,64), pb=pexu[ns];
        const float s0_=__shfl(g4a,ns,64),s1_=__shfl(g4b,ns,64),s2_=__shfl(g4c,ns,64),s3_=__shfl(g4d,ns,64); const int c_=lane&3;
        const float gl=(c_==0?s0_:c_==1?s1_:c_==2?s2_:s3_)+pb; const bool sk=(qn*knb+A+0.02f-gl<-70.0f);
        const unsigned long long m2=__ballot(lane<4&&sk)&0xfull; nt2=((m2&3ull)==3ull)?2:0; }
      if(lane==0){ ctl[1]=4*ns+nt2; ctl[2]=__float_as_int(flh[qb*QB]+pexu[qb]); }
    }
    __syncthreads();
    const int t0=ctl[1]; const float ref=__int_as_float(ctl[2]); const int kstart=t0*KVBLK, nk=qb*QB+QB-kstart;
    { const unsigned gdst=(unsigned)(uintptr_t)lds+(unsigned)gw_off; const float*src=flh+kstart; const int nch=(nk+255)>>8;
      for(int c=wid;c<nch;c+=NW) glds16s(src+c*256,(unsigned)lane*16u,(unsigned)__builtin_amdgcn_readfirstlane((int)(gdst+(unsigned)c*1024u))); }
    for(int i=tid;i<(nk>>6);i+=NW*64) offs[i]=pexu[(kstart+i*KVBLK)>>8]-ref;
    attn_unit<THRL>(b,h,qb,t0,Q,K,V,O,lds,(lds_fptr)gw,(lds_fptr)offs);
    }
    if(tid==0) ctl[3]=(int)nextq;
    __syncthreads();
  }
}
#undef SBAR
#undef WAIT_BAR
}

constexpr int NWAVES = 8;
constexpr int N_PHASES = 12;
constexpr size_t WS_SLOTRS = 8 * MiB + 64 * 1024;
constexpr size_t WS_NMAX = 8 * MiB + 512 * 1024;
constexpr size_t WS_WF = 9 * MiB;
constexpr size_t WS_WR = 9 * MiB + 64 * 1024;
constexpr size_t WS_WPOOL = 9 * MiB + 512 * 1024;
constexpr size_t WS_WO = 10 * MiB;
constexpr size_t WS_WQKV = 12 * MiB;
constexpr size_t WS_WD = 18 * MiB;
constexpr size_t WS_WGU = 24 * MiB;
constexpr size_t WS_WEGU = 36 * MiB;
constexpr size_t WS_WED = 92 * MiB;
constexpr size_t WS_X8 = 120 * MiB;
constexpr size_t WS2_XB = 204 * MiB;
constexpr size_t WS2_R = 268 * MiB;
constexpr size_t WS2_END = 500 * MiB;
constexpr int CW_BAR = 4096;
constexpr int CW_QUEUE = 16384;
constexpr size_t CTL_ZERO_BYTES = 128 * 1024;
static_assert((CW_QUEUE + 64) * 4 <= (int)CTL_ZERO_BYTES && (CW_BAR + 3456) * 4 <= (int)CTL_ZERO_BYTES, "control words inside the memset region");
constexpr int RING_BYTES = 131072;
constexpr int ATT_GW_OFF = 83968, ATT_P_OFF = ATT_GW_OFF + 65536 + 1024, MISC_OFF = ATT_P_OFF + 1024, ATT_TBL_OFF = MISC_OFF + 512  , ATT_OFFS_OFF = ATT_TBL_OFF + 8192  , LDS_BYTES = ATT_OFFS_OFF + 1024;
static_assert(LDS_BYTES <= 160 * 1024, "LDS");

#define XB_TMO      128
#define XB_XCNT(j)  (256  + 64 * (j))
#define XB_XSUB(j)  (1280 + 64 * (j))
#define XB_XGEN(j)  (2304 + 64 * (j))
#define XB_TOP      3328
#define XB_TOPGEN   3392
#define XCD_BAR_WORDS 3456
#define XB_SPIN_CAP (1u << 18)
__device__ __forceinline__ unsigned xb_ld(unsigned* p)              { return __hip_atomic_load(p, __ATOMIC_RELAXED, __HIP_MEMORY_SCOPE_AGENT); }
__device__ __forceinline__ unsigned xb_add(unsigned* p, unsigned v) { return __hip_atomic_fetch_add(p, v, __ATOMIC_RELAXED, __HIP_MEMORY_SCOPE_AGENT); }
__device__ __forceinline__ unsigned xb_xcc_id() { return (unsigned)__builtin_amdgcn_s_getreg((3 << 11) | 20) & 0xFu; }
#define XB_SPIN(cond, bar) do { unsigned _sp = 0; while (cond) { __builtin_amdgcn_s_sleep(1); \
    if ((++_sp & 255u) == 0u) { if (xb_ld(&(bar)[XB_TMO])) break; if (_sp > XB_SPIN_CAP) { atomicAdd(&(bar)[XB_TMO], 1u); break; } } } } while (0)
struct XcdBarrier { unsigned* bar; unsigned x; volatile LAS unsigned* st; };
__device__ __forceinline__ XcdBarrier xcd_barrier_post(unsigned* bar, volatile LAS unsigned* st, bool t0) {
    XcdBarrier b; b.bar = bar; b.x = xb_xcc_id(); b.st = st;
    if (t0) (void)xb_add(&bar[XB_XCNT(b.x)], 1u);
    return b;
}
__device__ __forceinline__ void xcd_barrier_complete(unsigned* bar, unsigned x, unsigned& nloc, unsigned& nx) {
    const unsigned G = gridDim.x * gridDim.y * gridDim.z;
    unsigned sum, cnt, mine, sp = 0u;
    for (;;) {
        sum = 0u; cnt = 0u; mine = 0u;
#pragma unroll
        for (unsigned j = 0; j < 16; ++j) { const unsigned c = xb_ld(&bar[XB_XCNT(j)]); sum += c; cnt += (c > 0u) ? 1u : 0u; mine = (j == x) ? c : mine; }
        if (sum == G) break;
        __builtin_amdgcn_s_sleep(1);
        if ((++sp & 255u) == 0u) { if (xb_ld(&bar[XB_TMO])) break; if (sp > XB_SPIN_CAP) { atomicAdd(&bar[XB_TMO], 1u); break; } }
    }
    nloc = mine > 0u ? mine : 1u; nx = cnt > 0u ? cnt : 1u;
}
__device__ __forceinline__ void xcd_barrier(const XcdBarrier& b, bool t0) {
    asm volatile("s_waitcnt vmcnt(0)" ::: "memory");
    __syncthreads();
    if (t0) {
        unsigned* bar = b.bar;
        __builtin_amdgcn_s_waitcnt(0);
        unsigned nloc = b.st[0], nx = b.st[1];
        if (nloc == 0u) { xcd_barrier_complete(bar, b.x, nloc, nx); b.st[0] = nloc; b.st[1] = nx; }
        const unsigned old = xb_add(&bar[XB_XSUB(b.x)], 1u);
        const unsigned gen = old / nloc;
        if (old + 1u == (gen + 1u) * nloc) {
            __builtin_amdgcn_fence(__ATOMIC_RELEASE, "agent");
            asm volatile("s_waitcnt vmcnt(0)" ::: "memory");
            const unsigned og = xb_add(&bar[XB_TOP], 1u);
            const unsigned tg = og / nx;
            if (og + 1u == (tg + 1u) * nx) xb_add(&bar[XB_TOPGEN], 1u);
            else XB_SPIN(xb_ld(&bar[XB_TOPGEN]) == tg, bar);
            __builtin_amdgcn_fence(__ATOMIC_ACQUIRE, "agent");
            xb_add(&bar[XB_XGEN(b.x)], 1u);
            asm volatile("s_waitcnt vmcnt(0)" ::: "memory");
        } else {
            XB_SPIN(xb_ld(&bar[XB_XGEN(b.x)]) == gen, bar);
            __builtin_amdgcn_fence(__ATOMIC_ACQUIRE, "agent");
            asm volatile("s_waitcnt vmcnt(0)" ::: "memory");
        }
    }
    __syncthreads();
}

#define KARG(i) (*(const float* const volatile __attribute__((address_space(4)))*)((const __attribute__((address_space(4))) char*)__builtin_amdgcn_kernarg_segment_ptr() + 8 * (i)))
struct Args { const float* in[18]; float* out; unsigned char* ws; int ph_lo, ph_hi, use_bar, pad; };
struct Ctx {
    LAS unsigned char* lds; int tid, lane, wave, vcu, G;
    float* out; unsigned char* ws;
};

template <bool FP8>
__device__ __forceinline__ void conv_item64(const float* W, int pitch, int k0, int n0, const float* gk, const float* gn, float cst, void* dst  , int dK, LAS float* scr, int lane) {
    const int nq = 4 * (lane & 15), kr = lane >> 4;
    f32x4 v[16];
#pragma unroll
    for (int i = 0; i < 16; ++i) v[i] = *(const f32x4*)(W + (size_t)(k0 + 4 * i + kr) * pitch + n0 + nq);
    f32x4 sn = (f32x4){cst, cst, cst, cst}; if (gn) sn = sn * *(const f32x4*)(gn + n0 + nq);
#pragma unroll
    for (int i = 0; i < 16; ++i) { const int kk = 4 * i + kr; const f32x4 w = v[i] * sn * (gk ? gk[k0 + kk] : 1.0f); LAS float* s = scr + kk * 65 + nq; s[0] = w[0]; s[1] = w[1]; s[2] = w[2]; s[3] = w[3]; }
    LDS_WAIT(); asm volatile("" ::: "memory");
    const int c = lane & 7;
#pragma unroll
    for (int j = 0; j < 8; ++j) { const int n = (lane >> 3) + 8 * j; const LAS float* s = scr + (8 * c) * 65 + n;
        if constexpr (FP8) { uint2 o; o.x = pg8::pk4_fp8(s[0 * 65], s[1 * 65], s[2 * 65], s[3 * 65]); o.y = pg8::pk4_fp8(s[4 * 65], s[5 * 65], s[6 * 65], s[7 * 65]);
            *(uint2*)((unsigned char*)dst + (size_t)n * dK + k0 + 8 * c) = o; }
        else { v4u o; o.x = pk2(s[0 * 65], s[1 * 65]); o.y = pk2(s[2 * 65], s[3 * 65]); o.z = pk2(s[4 * 65], s[5 * 65]); o.w = pk2(s[6 * 65], s[7 * 65]);
            *(GAS v4u*)((bf16*)dst + (size_t)n * dK + k0 + 8 * c) = o; } }
    LDS_WAIT(); asm volatile("" ::: "memory");
}
template <bool FP8>
__device__ __forceinline__ void conv_matrix_item(const float* W, int pitch, int K, int N, const float* gk, const float* gn, float cst, void* dst, int mode, int item, LAS float* scr, int lane) {
    const int nblk = N / 64, kb = item / nblk, nb = item - kb * nblk, n0 = 64 * nb;
    const int drow = mode == 0 ? n0 : (n0 >> 7) * 256 + (n0 & 127) + (mode == 2 ? 128 : 0);
    conv_item64<FP8>(W, pitch, 64 * kb, n0, gk, gn, cst, (unsigned char*)dst + (size_t)drow * K * (FP8 ? 1 : 2), K, scr, lane);
}
struct ConvD { const float* W; int pitch, k0, n0; const float* gk; unsigned char* dst; int dK; };
__device__ __forceinline__ ConvD expert_item(unsigned char* ws, int r) {
    constexpr int I_EGU = 16 * (FFE / 64), I_ED = (FFE / 64) * 16;
    const int e = r / (2 * I_EGU + I_ED); r -= e * (2 * I_EGU + I_ED);
    ConvD d; int mode, K, N;
    if (r < 2 * I_EGU) { const bool up = r >= I_EGU; if (up) r -= I_EGU; d.W = (up ? KARG(15) : KARG(14)) + (size_t)e * D * FFE; d.pitch = FFE; K = D; N = FFE; d.gk = KARG(2) + D; d.dst = ws + WS_WEGU + (size_t)e * 2 * FFE * D; mode = up ? 2 : 1; }
    else { r -= 2 * I_EGU; d.W = KARG(16) + (size_t)e * FFE * D; d.pitch = D; K = FFE; N = D; d.gk = nullptr; d.dst = ws + WS_WED + (size_t)e * D * FFE; mode = 0; }
    const int nblk = N / 64, kb = r / nblk, nb = r - kb * nblk, n0 = 64 * nb;
    const int drow = mode == 0 ? n0 : (n0 >> 7) * 256 + (n0 & 127) + (mode == 2 ? 128 : 0);
    d.k0 = 64 * kb; d.n0 = n0; d.dst += (size_t)drow * K; d.dK = K; return d;
}
__device__ __forceinline__ void conv_load(const ConvD& d, f32x4 (&v)[16], float& g, int lane) {
    const int nq = 4 * (lane & 15), kr = lane >> 4;
#pragma unroll
    for (int i = 0; i < 16; ++i) v[i] = __builtin_nontemporal_load((const f32x4*)(d.W + (size_t)(d.k0 + 4 * i + kr) * d.pitch + d.n0 + nq));
    g = 1.0f; if (d.gk) g = d.gk[d.k0 + lane];
}
__device__ __forceinline__ void conv_finish8(const ConvD& d, const f32x4 (&v)[16], float g, LAS float* scr, int lane) {
    const int nq = 4 * (lane & 15), kr = lane >> 4;
#pragma unroll
    for (int i = 0; i < 16; ++i) { const int kk = 4 * i + kr; const f32x4 w = v[i] * (__shfl(g, kk, 64) * 256.0f); LAS float* s = scr + kk * 65 + nq; s[0] = w[0]; s[1] = w[1]; s[2] = w[2]; s[3] = w[3]; }
    LDS_WAIT(); asm volatile("" ::: "memory");
    const int c = lane & 7;
#pragma unroll
    for (int j = 0; j < 8; ++j) { const int n = (lane >> 3) + 8 * j; const LAS float* s = scr + (8 * c) * 65 + n;
        uint2 o; o.x = pg8::pk4_fp8(s[0 * 65], s[1 * 65], s[2 * 65], s[3 * 65]); o.y = pg8::pk4_fp8(s[4 * 65], s[5 * 65], s[6 * 65], s[7 * 65]);
        typedef unsigned u32x2_t __attribute__((ext_vector_type(2))); __builtin_nontemporal_store((u32x2_t){o.x, o.y}, (u32x2_t*)(d.dst + (size_t)n * d.dK + d.k0 + 8 * c)); }
    LDS_WAIT(); asm volatile("" ::: "memory");
}
__device__ __forceinline__ void expert_conv_unit(unsigned char* ws, int cu, LAS unsigned char* lds) {
    int tid = threadIdx.x; asm volatile("" : "+v"(tid)); const int lane = tid & 63, wave = __builtin_amdgcn_readfirstlane(tid >> 6);
    LAS float* scr = (LAS float*)(lds + wave * 16640);
    const int base = cu * CONV_ITEMS_PER_UNIT + wave; constexpr int NQ = CONV_ITEMS_PER_UNIT / NWAVES;
    f32x4 vA[16], vB[16]; float gA, gB;
    ConvD dA = expert_item(ws, base), dB; conv_load(dA, vA, gA, lane);
#pragma unroll
    for (int q = 0; q < NQ; q += 2) {
        dB = expert_item(ws, base + (q + 1) * NWAVES); conv_load(dB, vB, gB, lane); __builtin_amdgcn_sched_barrier(0);
        conv_finish8(dA, vA, gA, scr, lane); __builtin_amdgcn_sched_barrier(0);
        if (q + 2 < NQ) { dA = expert_item(ws, base + (q + 2) * NWAVES); conv_load(dA, vA, gA, lane); __builtin_amdgcn_sched_barrier(0); }
        conv_finish8(dB, vB, gB, scr, lane); __builtin_amdgcn_sched_barrier(0);
    }
}
__device__ __forceinline__ void p0_prologue(Ctx& F) {
    unsigned char* ws = F.ws;
    {
        LAS float* xr = (LAS float*)F.lds;
        LAS float* rr = (LAS float*)(F.lds + 131072);
        bf16* pooled = (bf16*)(ws + WS2_R);
        const int lr = F.tid >> 8, lc = 4 * (F.tid & 255);
        const int c = 2 * F.tid, w = 2 << (F.tid >> 7);
        const float g0 = KARG(1)[c], g1 = KARG(1)[c + 1];
        for (int chunk = F.vcu; chunk < M / 128; chunk += F.G) {
            const int t0 = chunk * 128, first = (t0 % SEQ == 0) ? t0 : t0 - 15, nrows = t0 + 128 - first;
            const float* xg = KARG(0) + (size_t)first * D + lc;
            f32x4 nx[8];
#pragma unroll
            for (int j = 0; j < 8; ++j) { const int r = lr + 2 * j; nx[j] = r < nrows ? *(const f32x4*)(xg + (size_t)r * D) : (f32x4){0.f, 0.f, 0.f, 0.f}; }
            float s0 = 0.f, s1 = 0.f;
            for (int rb = 0; rb < nrows; rb += 16) {
#pragma unroll
                for (int j = 0; j < 8; ++j) *(LAS f32x4*)(xr + ((rb + lr + 2 * j) & 31) * 1024 + lc) = nx[j];
                if (rb + 16 < nrows) {
#pragma unroll
                    for (int j = 0; j < 8; ++j) { const int r = rb + 16 + lr + 2 * j; nx[j] = r < nrows ? *(const f32x4*)(xg + (size_t)r * D) : (f32x4){0.f, 0.f, 0.f, 0.f}; }
                }
                __syncthreads();
#pragma unroll
                for (int q = 0; q < 2; ++q) { const int r = rb + 2 * F.wave + q; LAS const f32x4* p = (LAS const f32x4*)(xr + (r & 31) * 1024) + F.lane; float s = 0.f;
#pragma unroll
                    for (int j = 0; j < 4; ++j) { const f32x4 v = p[64 * j]; s += (v[0] * v[0] + v[1] * v[1]) + (v[2] * v[2] + v[3] * v[3]); }
                    s = wave_sum(s); if (F.lane == 0) rr[r & 31] = 1.0f / sqrtf(s * (1.0f / D) + EPS); }
                __syncthreads();
                const int nb = nrows - rb < 16 ? nrows - rb : 16;
#pragma unroll 4
                for (int i = 0; i < nb; ++i) { const int r = rb + i;
                    const f32x2 xv = *(LAS const f32x2*)(xr + (r & 31) * 1024 + c); const float ri = rr[r & 31];
                    const float h0 = xv[0] * ri * g0, h1 = xv[1] * ri * g1; s0 += h0; s1 += h1;
                    if (r >= w) { const f32x2 xo = *(LAS const f32x2*)(xr + ((r - w) & 31) * 1024 + c); const float ro = rr[(r - w) & 31]; s0 -= xo[0] * ro * g0; s1 -= xo[1] * ro * g1; }
                    if (first + r >= t0) { const int ts = (first + r) % SEQ; const float ic = 1.0f / (float)(ts + 1 < w ? ts + 1 : w);
                        *(unsigned*)(pooled + (size_t)(first + r) * D + c) = pk2(s0 * ic - h0, s1 * ic - h1); }
                }
                __syncthreads();
            }
        }
    }
    {
        LAS float* scr = (LAS float*)(F.lds + F.wave * 16640);
        const int gw = F.vcu * NWAVES + F.wave, NGW = F.G * NWAVES;
        constexpr int I_POOL = 4 * 4, I_DGU = 16 * (FFD / 64), I_DD = (FFD / 64) * 16, I_SQ = 16 * 16;
        constexpr int NITEMS = 4 * I_POOL + 2 * I_DGU + I_DD + 4 * I_SQ;
        bf16* wpool = (bf16*)(ws + WS_WPOOL); bf16* wo = (bf16*)(ws + WS_WO); bf16* wqkv = (bf16*)(ws + WS_WQKV); bf16* wd = (bf16*)(ws + WS_WD); bf16* wgu = (bf16*)(ws + WS_WGU);
        for (int it = gw; it < NITEMS; it += NGW) {
            int r = it;
            if (r < 4 * I_POOL) { const int g = r / I_POOL; conv_matrix_item<false>(KARG(3) + (size_t)g * 65536, 256, 256, 256, nullptr, KARG(4) + g * 256, 1.0f, wpool + (size_t)g * 65536, 0, r % I_POOL, scr, F.lane); continue; } r -= 4 * I_POOL;
            if (r < I_DGU) { conv_matrix_item<false>(KARG(10), FFD, D, FFD, KARG(2), nullptr, 1.0f, wgu, 1, r, scr, F.lane); continue; } r -= I_DGU;
            if (r < I_DGU) { conv_matrix_item<false>(KARG(11), FFD, D, FFD, KARG(2), nullptr, 1.0f, wgu, 2, r, scr, F.lane); continue; } r -= I_DGU;
            if (r < I_DD) { conv_matrix_item<false>(KARG(12), D, FFD, D, nullptr, nullptr, 1.0f, wd, 0, r, scr, F.lane); continue; } r -= I_DD;
            if (r < I_SQ) { conv_matrix_item<false>(KARG(8), D, D, D, KARG(1) + D, nullptr, C2, wqkv, 0, r, scr, F.lane); continue; } r -= I_SQ;
            if (r < I_SQ) { conv_matrix_item<false>(KARG(6), KVW, D, D, KARG(5), nullptr, 1.0f, wqkv + (size_t)D * D, 0, r, scr, F.lane); continue; } r -= I_SQ;
            if (r < I_SQ) { conv_matrix_item<false>(KARG(6) + D, KVW, D, D, KARG(5), nullptr, 1.0f, wqkv + (size_t)2 * D * D, 0, r, scr, F.lane); continue; } r -= I_SQ;
            conv_matrix_item<false>(KARG(9), D, D, D, nullptr, nullptr, 1.0f, wo, 0, r, scr, F.lane);
        }
        bf16* wfh = (bf16*)(ws + WS_WF); bf16* wrh = (bf16*)(ws + WS_WR);
        for (int i = F.vcu * 512 + F.tid; i < 2 * NH * D; i += F.G * 512) {
            const int which = i >> 14, j = i & 16383, row = j >> 10, kk = j & 1023; float w;
            if (which == 0) w = KARG(6)[(size_t)kk * KVW + 2 * D + row] * KARG(5)[kk]; else w = row < NE ? KARG(13)[kk * NE + row] * KARG(2)[D + kk] : 0.0f;
            const bf16 h = f2bf(w), l = f2bf(w - bf2f(h)); bf16* t = which == 0 ? wfh : wrh; t[j] = h; t[NH * D + j] = l;
        }
    }
}


__device__ __forceinline__ void fgate_tile(Ctx& F, int tile) {
    unsigned char* ws = F.ws; const bf16* xb = (const bf16*)(ws + WS2_XB); const float* wf = (const float*)(ws + WS_WF); const float* stats = (const float*)(ws + WS_STATS);
    float* fl = (float*)(ws + WS_FL); float* ftot = (float*)(ws + WS_FTOT);
    LAS float* zt = (LAS float*)F.lds;
    const int fr = F.lane & 15, fq = F.lane >> 4, row0 = tile * 256 + F.wave * 32;
    f32x4 acc[2] = {(f32x4){0.f, 0.f, 0.f, 0.f}, (f32x4){0.f, 0.f, 0.f, 0.f}};
    const bf16* xa = xb + (size_t)(row0 + fr) * D + 8 * fq; const bf16* wb = (const bf16*)wf + (size_t)fr * D + 8 * fq;
#pragma unroll 8
    for (int s = 0; s < 32; ++s) {
        const bf16x8 bh = *(const bf16x8*)(wb + 32 * s), bl = *(const bf16x8*)(wb + NH * D + 32 * s);
#pragma unroll
        for (int rg = 0; rg < 2; ++rg) { const bf16x8 a = *(const bf16x8*)(xa + (size_t)rg * 16 * D + 32 * s);
            acc[rg] = __builtin_amdgcn_mfma_f32_16x16x32_bf16(a, bh, acc[rg], 0, 0, 0); acc[rg] = __builtin_amdgcn_mfma_f32_16x16x32_bf16(a, bl, acc[rg], 0, 0, 0); }
    }
    const float bfh = KARG(7)[fr];
#pragma unroll
    for (int rg = 0; rg < 2; ++rg)
#pragma unroll
        for (int i = 0; i < 4; ++i) { const int rl = F.wave * 32 + rg * 16 + 4 * fq + i; const float z = acc[rg][i] * pg8::rinv_from_stats(stats, tile * 256 + rl) + bfh;
            zt[rl * 17 + fr] = (fminf(z, 0.f) - log1pf(__expf(-fabsf(z)))) * LOG2E; }
    __syncthreads();
    { const int h = 2 * F.wave + (F.lane >> 5), seg = F.lane & 31; float v[8]; float s = 0.f;
#pragma unroll
      for (int i = 0; i < 8; ++i) { s += zt[(seg * 8 + i) * 17 + h]; v[i] = s; }
      float inc = s;
#pragma unroll
      for (int o = 1; o < 32; o <<= 1) { const float t = __shfl_up(inc, o, 32); if (seg >= o) inc += t; }
      const float pre = inc - s; const int b = tile / NTILE, tl = tile % NTILE;
      float* fo = fl + ((size_t)b * NH + h) * SEQ + tl * 256 + seg * 8;
      *(f32x4*)fo = (f32x4){v[0] + pre, v[1] + pre, v[2] + pre, v[3] + pre}; *(f32x4*)(fo + 4) = (f32x4){v[4] + pre, v[5] + pre, v[6] + pre, v[7] + pre};
      if (seg == 31) ftot[((size_t)b * NTILE + tl) * NH + h] = inc; }
    __syncthreads();
}


__device__ __forceinline__ void router_tile(Ctx& F, int hc) {
    unsigned char* ws = F.ws; const bf16* xb = (const bf16*)(ws + WS2_XB); const float* wrt = (const float*)(ws + WS_WR); const float* stats = (const float*)(ws + WS_STATS);
    int* toke = (int*)(ws + WS_TOKE); float* tokw = (float*)(ws + WS_TOKW); float* rinv3 = (float*)(ws + WS_RINV3); int* chist = (int*)(ws + WS_CHIST);
    LAS float* lg = (LAS float*)F.lds;
    LAS int* cnt = (LAS int*)(F.lds + 128 * 9 * 4);
    const int fr = F.lane & 15, fq = F.lane >> 4, row0 = hc * 128 + F.wave * 16;
    if (F.tid < NE) cnt[F.tid] = 0;
    f32x4 acc = (f32x4){0.f, 0.f, 0.f, 0.f};
    const bf16* xa = xb + (size_t)(row0 + fr) * D + 8 * fq; const bf16* wb = (const bf16*)wrt + (size_t)fr * D + 8 * fq;
    const float ri8 = pg8::rinv_from_stats(stats, row0 + fr) * 8.0f; unsigned char* x8r = ws + WS_X8 + (size_t)(row0 + fr) * D + 8 * fq;
#pragma unroll 8
    for (int s = 0; s < 32; ++s) {
        const bf16x8 bh = *(const bf16x8*)(wb + 32 * s), bl = *(const bf16x8*)(wb + NH * D + 32 * s), a = *(const bf16x8*)(xa + 32 * s);
        acc = __builtin_amdgcn_mfma_f32_16x16x32_bf16(a, bh, acc, 0, 0, 0); acc = __builtin_amdgcn_mfma_f32_16x16x32_bf16(a, bl, acc, 0, 0, 0);
        const v4u aw = __builtin_bit_cast(v4u, a); uint2 p8;
        p8.x = pg8::pk4_fp8(__uint_as_float(aw[0] << 16) * ri8, __uint_as_float(aw[0] & 0xffff0000u) * ri8, __uint_as_float(aw[1] << 16) * ri8, __uint_as_float(aw[1] & 0xffff0000u) * ri8);
        p8.y = pg8::pk4_fp8(__uint_as_float(aw[2] << 16) * ri8, __uint_as_float(aw[2] & 0xffff0000u) * ri8, __uint_as_float(aw[3] << 16) * ri8, __uint_as_float(aw[3] & 0xffff0000u) * ri8);
        *(uint2*)(x8r + 32 * s) = p8;
    }
    if (fr < NE) {
#pragma unroll
        for (int i = 0; i < 4; ++i) lg[(F.wave * 16 + 4 * fq + i) * 9 + fr] = acc[i];
    }
    __syncthreads();
    if (F.tid < 128) { const int t = hc * 128 + F.tid; float v[NE];
#pragma unroll
        for (int e = 0; e < NE; ++e) v[e] = lg[F.tid * 9 + e];
        int e0 = 0; float v0 = v[0];
#pragma unroll
        for (int e = 1; e < NE; ++e) if (v[e] > v0) { v0 = v[e]; e0 = e; }
        int e1 = -1; float v1 = -3e38f;
#pragma unroll
        for (int e = 0; e < NE; ++e) if (e != e0 && v[e] > v1) { v1 = v[e]; e1 = e; }
        const float ri = pg8::rinv_from_stats(stats, t), w0 = 1.0f / (1.0f + __expf((v1 - v0) * ri));
        rinv3[t] = ri; *(int2*)(toke + 2 * t) = make_int2(e0, e1); *(float2*)(tokw + 2 * t) = make_float2(w0, 1.0f - w0);
        __hip_atomic_fetch_add(cnt + e0, 1, __ATOMIC_RELAXED, __HIP_MEMORY_SCOPE_WORKGROUP); __hip_atomic_fetch_add(cnt + e1, 1, __ATOMIC_RELAXED, __HIP_MEMORY_SCOPE_WORKGROUP); }
    __syncthreads();
    if (F.tid < NE) chist[hc * NE + F.tid] = cnt[F.tid];
    __syncthreads();
}
__device__ __forceinline__ void lists_phase(Ctx& F) {
    unsigned char* ws = F.ws; const int* chist = (const int*)(ws + WS_CHIST); const int* toke = (const int*)(ws + WS_TOKE); const float* tokw = (const float*)(ws + WS_TOKW);
    const float* rinv3 = (const float*)(ws + WS_RINV3); int* tilee = (int*)(ws + WS_TILEE); int* slottok = (int*)(ws + WS_SLOTTOK); int2* slotinfo = (int2*)(ws + WS_SLOTINFO); float* slotrs = (float*)(ws + WS_SLOTRS);
    LAS int* coffL = (LAS int*)F.lds;
    LAS int* tot = coffL + 128 * NE; LAS int* pbase = tot + NE;
    LAS unsigned long long* bal = (LAS unsigned long long*)(F.lds + 8192);
    { const int e = F.wave, j = F.lane; const int a = chist[(4 * j) * NE + e] + chist[(4 * j + 1) * NE + e], b = chist[(4 * j + 2) * NE + e] + chist[(4 * j + 3) * NE + e], s = a + b; int inc = s;
#pragma unroll
      for (int o = 1; o < 64; o <<= 1) { const int t = __shfl_up(inc, o, 64); if (j >= o) inc += t; }
      coffL[(2 * j) * NE + e] = inc - s; coffL[(2 * j + 1) * NE + e] = inc - s + a; if (j == 63) tot[e] = inc; }
    __syncthreads();
    if (F.tid == 0) { int p = 0; for (int e = 0; e < NE; ++e) { pbase[e] = p; p += (tot[e] + 255) / 256 * 256; } pbase[NE] = p; }
    __syncthreads();
    if (blockIdx.x == 0) {
        for (int tl = F.tid; tl < MAXT; tl += NWAVES * 64) { int e = 0; while (e < NE - 1 && tl * 256 >= pbase[e + 1]) ++e; tilee[tl] = e; }
        if (F.tid == 0) tilee[300] = pbase[NE] / 256;
        for (int e = 0; e < NE; ++e) for (int s = pbase[e] + tot[e] + F.tid; s < pbase[e + 1]; s += NWAVES * 64) { slottok[s] = 0; slotinfo[s] = make_int2(-1, 0); slotrs[s] = 0.f; }
    }
    for (int ch = F.vcu; ch < M / 256; ch += F.G) {
        const int i = F.tid, e = toke[ch * 512 + i];
#pragma unroll
        for (int x = 0; x < NE; ++x) { const unsigned long long bm = __ballot(e == x); if (F.lane == 0) bal[F.wave * NE + x] = bm; }
        __syncthreads();
        int pos = __popcll(bal[F.wave * NE + e] & ((1ull << F.lane) - 1ull));
        for (int w2 = 0; w2 < F.wave; ++w2) pos += __popcll(bal[w2 * NE + e]);
        const int slot = pbase[e] + coffL[ch * NE + e] + pos, yrow = ch * 512 + i;
        slottok[slot] = yrow >> 1; slotinfo[slot] = make_int2(yrow, __float_as_int(tokw[yrow])); slotrs[slot] = rinv3[yrow >> 1];
        __syncthreads();
    }
}
__device__ __forceinline__ void final_phase(Ctx& F) {
    const bf16* xb = (const bf16*)(F.ws + WS2_XB);
    f32x4 g[2][2];
#pragma unroll
    for (int j = 0; j < 2; ++j) { const int c = (F.lane + 64 * j) * 8; g[j][0] = *(const f32x4*)(KARG(17) + c); g[j][1] = *(const f32x4*)(KARG(17) + c + 4); }
    const int step = F.G * NWAVES;
    for (int t0 = F.vcu * NWAVES + F.wave; t0 < M; t0 += 2 * step) {
        v4u a[2][2], y0[2][2], y1[2][2];
#pragma unroll
        for (int k2 = 0; k2 < 2; ++k2) { const int t = t0 + k2 * step; if (t < M) { const v4u* yr = (const v4u*)((const bf16*)F.out + (size_t)t * 2 * D); const v4u* xr = (const v4u*)(xb + (size_t)t * D);
#pragma unroll
            for (int j = 0; j < 2; ++j) { a[k2][j] = xr[F.lane + 64 * j]; y0[k2][j] = yr[F.lane + 64 * j]; y1[k2][j] = yr[128 + F.lane + 64 * j]; } } }
#pragma unroll
        for (int k2 = 0; k2 < 2; ++k2) { const int t = t0 + k2 * step; if (t < M) { float v[16]; float s = 0.f;
#pragma unroll
            for (int j = 0; j < 2; ++j)
#pragma unroll
                for (int q = 0; q < 4; ++q) { const float lo = __uint_as_float(a[k2][j][q] << 16) + __uint_as_float(y0[k2][j][q] << 16) + __uint_as_float(y1[k2][j][q] << 16);
                    const float hi = __uint_as_float(a[k2][j][q] & 0xffff0000u) + __uint_as_float(y0[k2][j][q] & 0xffff0000u) + __uint_as_float(y1[k2][j][q] & 0xffff0000u);
                    v[j * 8 + 2 * q] = lo; v[j * 8 + 2 * q + 1] = hi; s += lo * lo + hi * hi; }
            s = wave_sum(s); const float ri = 1.0f / sqrtf(s * (1.0f / D) + EPS);
#pragma unroll
            for (int j = 0; j < 2; ++j) { float* o = F.out + (size_t)t * D + (F.lane + 64 * j) * 8;
                *(f32x4*)o = (f32x4){v[j * 8] * ri * g[j][0][0], v[j * 8 + 1] * ri * g[j][0][1], v[j * 8 + 2] * ri * g[j][0][2], v[j * 8 + 3] * ri * g[j][0][3]};
                *(f32x4*)(o + 4) = (f32x4){v[j * 8 + 4] * ri * g[j][1][0], v[j * 8 + 5] * ri * g[j][1][1], v[j * 8 + 6] * ri * g[j][1][2], v[j * 8 + 7] * ri * g[j][1][3]}; } } }
    }
}

__global__ void __launch_bounds__(NWAVES * 64, 2) mk_fwd(Args args) {
    extern __shared__ __attribute__((aligned(16))) unsigned char lds[];
    Ctx F;
    F.lds = (LAS unsigned char*)lds; F.tid = threadIdx.x; F.lane = F.tid & 63; F.wave = __builtin_amdgcn_readfirstlane(F.tid >> 6);
    F.G = gridDim.x; { const int bx = blockIdx.x; F.vcu = (F.G % 8 == 0) ? (bx % 8) * (F.G / 8) + bx / 8 : bx; }
    F.out = args.out; F.ws = args.ws;
    unsigned char* ws = args.ws;
    unsigned* ctl = (unsigned*)(ws + WS_CTL);
    volatile LAS unsigned* MISC = (volatile LAS unsigned*)(F.lds + MISC_OFF);
    for (int u = F.tid; u < 128; u += NWAVES * 64) MISC[u] = 0u;
    __syncthreads();
    XcdBarrier bar; bar.bar = ctl + CW_BAR; bar.x = 0; bar.st = nullptr;
    if (args.use_bar) bar = xcd_barrier_post(ctl + CW_BAR, MISC + 8, F.wave == 0 && lane_id() == 0);
    const int lo = args.ph_lo, hi = args.ph_hi;
#define IN(k) (lo <= (k) && (k) < hi)
#define REFRESH() do { int l_ = lane_id(); asm volatile("" : "+v"(l_)); F.lane = l_; F.tid = F.wave * 64 + l_; } while (0)
#define SEAM(k) do { if (IN(k) && IN((k) + 1)) xcd_barrier(bar, F.wave == 0 && lane_id() == 0); } while (0)
    bf16* xb = (bf16*)(ws + WS2_XB); float* stats = (float*)(ws + WS_STATS);

    if (IN(0)) { REFRESH(); p0_prologue(F); } SEAM(0);
    if (IN(1)) {
        pg8::Gemm g{(const bf16*)(ws + WS2_R), (const bf16*)(ws + WS_WPOOL), D, 256, 256};
        pg8::RegOrder S; S.init(M, D, F.G, (int)blockIdx.x, D, 256, 512u);
        pg8::EpiRes E{KARG(0), xb, stats, nullptr};
        pg8::gemm_phase<pg8::EpiRes, pg8::RegOrder, true>(F.lds, g, S, E);
    } SEAM(1);
    if (IN(2)) {
        pg8::Gemm g{xb, (const bf16*)(ws + WS_WGU), D, D, D};
        pg8::RegOrder S; S.init(M, 2 * FFD, F.G, (int)blockIdx.x, D, D, 0u);
        pg8::EpiGU E{(bf16*)(ws + WS2_R), FFD, stats, {{0.f, 0.f, 0.f, 0.f}, {0.f, 0.f, 0.f, 0.f}}, -1};
        pg8::gemm_phase<pg8::EpiGU, pg8::RegOrder, true>(F.lds, g, S, E);
    } SEAM(2);
    if (IN(3)) {
        pg8::Gemm g{(const bf16*)(ws + WS2_R), (const bf16*)(ws + WS_WD), FFD, FFD, FFD};
        pg8::RegOrder S; S.init(M, D, F.G, (int)blockIdx.x, FFD, FFD, 0u);
        pg8::EpiRes E{nullptr, xb, stats, nullptr};
        pg8::gemm_phase<pg8::EpiRes, pg8::RegOrder, true>(F.lds, g, S, E);
    } SEAM(3);
    if (IN(4)) {
        REFRESH(); for (int tile = F.vcu; tile < M / 256; tile += F.G) fgate_tile(F, tile);
        { const int idle = F.G > M / 256 ? F.G - M / 256 : 0;
          if (F.vcu >= M / 256 && F.vcu - M / 256 < CONV_P4) { expert_conv_unit(ws, N_CONV_UNITS + F.vcu - M / 256, F.lds); __syncthreads(); }
          for (int u = idle + F.vcu; u < CONV_P4; u += F.G) { expert_conv_unit(ws, N_CONV_UNITS + u, F.lds); __syncthreads(); } }
        pg8::Gemm g{xb, (const bf16*)(ws + WS_WQKV), D, D, D};
        pg8::RegOrder S; S.init(M, 3 * D, F.G, (int)blockIdx.x, D, D, 0u);
        pg8::EpiQKV E{(bf16*)(ws + WS2_R), (size_t)32 * MiB, stats, (float*)(ws + WS_NMAX)};
        pg8::gemm_phase<pg8::EpiQKV, pg8::RegOrder, true>(F.lds, g, S, E);
    } SEAM(4);
    if (IN(5)) {
        attn_body::attn_phase<8>(ws, (char*)lds, ATT_GW_OFF, ATT_P_OFF, ATT_TBL_OFF, ATT_OFFS_OFF, (const attn_body::bf16*)(ws + WS2_R), (const attn_body::bf16*)(ws + WS2_R + 64 * MiB), (const attn_body::bf16*)(ws + WS2_R + 128 * MiB),
                                 (attn_body::bf16*)(ws + WS2_R), (const float*)(ws + WS_FL), (const float*)(ws + WS_FTOT), (const float*)(ws + WS_NMAX), ctl + CW_QUEUE);
    } SEAM(5);
    if (IN(6)) {
        pg8::Gemm g{(const bf16*)(ws + WS2_R), (const bf16*)(ws + WS_WO), D, D, D};
        pg8::RegOrder S; S.init(M, D, F.G, (int)blockIdx.x, D, D, 0u);
        pg8::EpiRes E{nullptr, xb, stats, nullptr};
        pg8::gemm_phase<pg8::EpiRes, pg8::RegOrder, true>(F.lds, g, S, E);
    } SEAM(6);
    if (IN(7)) { REFRESH(); for (int hc = F.vcu; hc < M / 128; hc += F.G) router_tile(F, hc); } SEAM(7);
    if (IN(8)) { REFRESH(); lists_phase(F); } SEAM(8);
    if (IN(9)) {
        const int ntl = ((const int*)(ws + WS_TILEE))[300]; LAS int* tl = (LAS int*)(F.lds + pg8::STAGE_BYTES + 8192);
        { int t_ = F.wave * 64 + lane_id(); asm volatile("" : "+v"(t_)); for (int i = t_; i < ntl; i += NWAVES * 64) tl[i] = ((const int*)(ws + WS_TILEE))[i]; }
        __syncthreads();
        pg8::Gemm g{(const bf16*)(ws + WS_X8), (const bf16*)(ws + WS_WEGU), D, D, D};
        pg8::MoeOrder<true> S{ntl, FFE / 128, F.G, (int)blockIdx.x, tl, (const int*)(ws + WS_SLOTTOK), 0u, (unsigned)(2 * FFE * D), (unsigned)(256 * D), 8};
        pg8::EpiGU8 E{ws + WS2_R, FFE};
        pg8::gemm_phase<pg8::EpiGU8, pg8::MoeOrder<true>, true, 1, false, false>(F.lds, g, S, E);
    } SEAM(9);
    if (IN(10)) {
        const int ntl = ((const int*)(ws + WS_TILEE))[300]; LAS int* tl = (LAS int*)(F.lds + pg8::STAGE_BYTES + 8192);
        { int t_ = F.wave * 64 + lane_id(); asm volatile("" : "+v"(t_)); for (int i = t_; i < ntl; i += NWAVES * 64) tl[i] = ((const int*)(ws + WS_TILEE))[i]; }
        __syncthreads();
        pg8::Gemm g{(const bf16*)(ws + WS2_R), (const bf16*)(ws + WS_WED), FFE, FFE, FFE};
        pg8::MoeOrder<false> S{ntl, D / 256, F.G, (int)blockIdx.x, tl, nullptr, (unsigned)(256 * FFE), (unsigned)(D * FFE), (unsigned)(256 * FFE), 8};
        pg8::EpiMoeD E{(bf16*)F.out, (const int2*)(ws + WS_SLOTINFO), 1.0f / 2048.0f};
        pg8::gemm_phase<pg8::EpiMoeD, pg8::MoeOrder<false>, true, 1>(F.lds, g, S, E);
    } SEAM(10);
    if (IN(11)) { REFRESH(); final_phase(F); }
#undef IN
#undef REFRESH
#undef SEAM
}

static int mk_grid = 0;
static bool mk_setup() {
    if (mk_grid == 0) {
        int dev = 0, cus = 0;
        if (hipGetDevice(&dev) != hipSuccess || hipDeviceGetAttribute(&cus, hipDeviceAttributeMultiprocessorCount, dev) != hipSuccess) { fprintf(stderr, "mk_setup: device query failed\n"); mk_grid = -1; return false; }
        if (hipFuncSetAttribute((const void*)mk_fwd, hipFuncAttributeMaxDynamicSharedMemorySize, LDS_BYTES) != hipSuccess) { fprintf(stderr, "mk_setup: hipFuncSetAttribute failed\n"); mk_grid = -1; return false; }
        int per_cu = 0;
        if (hipOccupancyMaxActiveBlocksPerMultiprocessor(&per_cu, (const void*)mk_fwd, NWAVES * 64, LDS_BYTES) != hipSuccess || per_cu < 1) fprintf(stderr, "mk_setup: occupancy query reports %d\n", per_cu);
        (void)hipGetLastError();
        mk_grid = cus;
    }
    return mk_grid > 0;
}
static void mk_launch(void* const* d_in, void* d_out, void* d_ws, int lo, int hi, hipStream_t stream) {
    Args a{};
    for (int i = 0; i < 18; ++i) a.in[i] = (const float*)d_in[i];
    a.out = (float*)d_out; a.ws = (unsigned char*)d_ws; a.ph_lo = lo; a.ph_hi = hi; a.use_bar = (hi - lo > 1) ? 1 : 0; a.pad = 0;
    hipLaunchKernelGGL(mk_fwd, dim3(mk_grid), dim3(NWAVES * 64), LDS_BYTES, stream, a);
}

extern "C" void kernel_launch(void* const* d_in, const int* in_sizes, int n_in, void* d_out, int out_size, void* d_ws, size_t ws_size, hipStream_t stream) {
    if (n_in != 18 || in_sizes[0] != M * D || out_size != M * D || ws_size < WS2_END) { fprintf(stderr, "kernel_launch: unexpected shapes (n_in %d, ws %zu < %zu); nothing launched\n", n_in, ws_size, (size_t)WS2_END); return; }
    if (!mk_setup()) return;
    (void)hipMemsetAsync((unsigned char*)d_ws + WS_CTL, 0, CTL_ZERO_BYTES, stream);
    mk_launch(d_in, d_out, d_ws, 0, N_PHASES, stream);
}
```

```cpp
#include <hip/hip_runtime.h>
#include <cstdint>
#include <cstdio>

typedef unsigned short bf16;
constexpr int NB = 2, SEQ = 16384, D = 1024, M = NB * SEQ, NH = 16, HD = 64, FFD = 2816, NE = 8, FFE = 3584, FFH = 1792;
constexpr int KVW = 2 * D + NH;
constexpr float EPS = 1e-5f, LOG2E = 1.4426950408889634f, C2 = 0.125f * LOG2E;
constexpr int NTILE = SEQ / 256;
constexpr int MAXSLOT = 2 * M + NE * 256;
constexpr int MAXT = MAXSLOT / 256;

constexpr size_t MiB = 1u << 20;
constexpr size_t WS_CTL = 0;
constexpr size_t WS_STATS = 1 * MiB;
constexpr size_t WS_RINV3 = 3 * MiB + 128 * 1024;
constexpr size_t WS_FL = 4 * MiB;
constexpr size_t WS_FTOT = 6 * MiB;
constexpr size_t WS_TOKE = 6 * MiB + 64 * 1024;
constexpr size_t WS_TOKW = WS_TOKE + 256 * 1024;
constexpr size_t WS_CHIST = WS_TOKW + 256 * 1024;
constexpr size_t WS_TILEE = WS_CHIST + 8192;
constexpr size_t WS_SLOTTOK = 7 * MiB;
constexpr size_t WS_SLOTINFO = WS_SLOTTOK + 512 * 1024;

__device__ __forceinline__ float bf2f(bf16 v) { return __builtin_bit_cast(float, (unsigned)v << 16); }
__device__ __forceinline__ bf16 f2bf(float f) { unsigned u = __builtin_bit_cast(unsigned, f); return (bf16)((u + 0x7fffu + ((u >> 16) & 1u)) >> 16); }
__device__ __forceinline__ float wave_sum(float v) {
#pragma unroll
    for (int o = 1; o < 64; o <<= 1) v += __shfl_xor(v, o);
    return v;
}

#define LAS __attribute__((address_space(3)))
#define GAS __attribute__((address_space(1)))
typedef unsigned v4u __attribute__((ext_vector_type(4)));
typedef float f32x4 __attribute__((ext_vector_type(4)));
typedef float f32x2 __attribute__((ext_vector_type(2)));
typedef short bf16x8 __attribute__((ext_vector_type(8)));
#define LDS_WAIT() asm volatile("s_waitcnt lgkmcnt(0)" ::: "memory")
#define VM_WAIT() asm volatile("s_waitcnt vmcnt(0)" ::: "memory")
__device__ __forceinline__ unsigned pk2(float lo, float hi) { return (unsigned)f2bf(lo) | ((unsigned)f2bf(hi) << 16); }

__device__ __forceinline__ int lane_id() { return (int)__builtin_amdgcn_mbcnt_hi(~0u, __builtin_amdgcn_mbcnt_lo(~0u, 0u)); }
namespace pg8 {
#define PG8_LAS __attribute__((address_space(3)))
typedef unsigned short bf16_t;
typedef unsigned u32x4 __attribute__((ext_vector_type(4)));
constexpr int BM = 256, BK = 64, HALF = 128, HTB = HALF * BK * 2  , STAGE_BYTES = 8 * HTB, NXCD = 8, WGM = 8;
__host__ __device__ __forceinline__ int lds_byte(int r, int c) { const int st = (r >> 4) * 2 + (c >> 5), rr = r & 15, cc = c & 31, ob = rr * 64 + cc * 2; return st * 1024 + (ob ^ (((ob >> 9) & 1) << 5)); }
__host__ __device__ __forceinline__ void stage_rc(int b, int& R, int& C) { const int st = b / 1024, sb = b % 1024, swz = sb ^ (((sb >> 9) & 1) << 5); R = (st >> 1) * 16 + swz / 64; C = (st & 1) * 32 + (swz % 64) / 2; }
__host__ __device__ __forceinline__ int perm32(int rho) { const int n = rho >> 4, i = rho & 15; return 8 * (i >> 2) + 4 * n + (i & 3); }

struct Unit { int pm, pn; unsigned aoff, boff; };
struct Gemm { const bf16_t* A; const bf16_t* Bt; int lda, ldb, K; };

struct RegOrder {
    static constexpr bool GATHER = false;
    int nM, nN, nwg, G, c; unsigned a_tile, a_pn, b_tile;
    __device__ __forceinline__ void init(int M_, int N_, int G_, int c_, int lda, int ldb, unsigned a_pn_) { nM = M_ / BM; nN = N_ / BM; nwg = nM * nN; G = G_; c = c_; a_tile = 256u * (unsigned)lda * 2u; b_tile = 256u * (unsigned)ldb * 2u; a_pn = a_pn_; }
    __device__ __forceinline__ bool next(int i, Unit& u) const {
        const long L = (long)i * G + c; if (L >= nwg) return false;
        int wgid = (int)L; { const int q = nwg / NXCD, r = nwg % NXCD, xcd = wgid % NXCD, off = wgid / NXCD; wgid = (xcd < r ? xcd * (q + 1) : r * (q + 1) + (xcd - r) * q) + off; }
        const int nig = WGM * nN, gid = wgid / nig, fm = gid * WGM, gsz = (nM - fm) < WGM ? (nM - fm) : WGM;
        u.pm = fm + ((wgid % nig) % gsz); u.pn = (wgid % nig) / gsz; u.aoff = (unsigned)u.pm * a_tile + (unsigned)u.pn * a_pn; u.boff = (unsigned)u.pn * b_tile; return true;
    }
    __device__ __forceinline__ int tok(int) const { return 0; }
};
template <bool G_> struct MoeOrder {
    static constexpr bool GATHER = G_;
    int ntiles, npn, G, c; const PG8_LAS int* tilee; const int* list; unsigned a_tile, e_stride, b_tile; int GM;
    __device__ __forceinline__ bool next(int i, Unit& u) const {
        if (G % NXCD != 0) { const int L = i * G + c; if (L >= ntiles * npn) return false; u.pn = L / ntiles; u.pm = L - u.pn * ntiles; }
        else {
            const int x = c % NXCD, j = c / NXCD, nw = G / NXCD, t_lo = x * ntiles / NXCD, nt_x = (x + 1) * ntiles / NXCD - t_lo, q = i * nw + j;
            if (q >= nt_x * npn) return false;
            const int per = GM * npn, nfull = nt_x / GM, grp = q / per;
            int base, gsz, r;
            if (grp < nfull) { base = grp * GM; gsz = GM; r = q - grp * per; } else { base = nfull * GM; gsz = nt_x - base; r = q - nfull * per; }
            const int pn = r / gsz; u.pn = pn; u.pm = t_lo + base + (r - pn * gsz);
        }
        const int e = tilee[u.pm]; u.aoff = (unsigned)u.pm * a_tile; u.boff = (unsigned)e * e_stride + (unsigned)u.pn * b_tile; return true;
    }
    __device__ __forceinline__ int tok(int slot) const { return list[slot]; }
};

__device__ __forceinline__ unsigned cvt_pk_bf16(float lo, float hi) { unsigned r; asm volatile("v_cvt_pk_bf16_f32 %0, %1, %2" : "=v"(r) : "v"(lo), "v"(hi)); return r; }
__device__ __forceinline__ float rinv_from_stats(const float* stats, int row) {
    const f32x4* p = (const f32x4*)(stats + (size_t)row * 16); const f32x4 a = p[0], b = p[1], c = p[2], d = p[3];
    const float s = (((a[0] + a[1]) + (a[2] + a[3])) + ((b[0] + b[1]) + (b[2] + b[3]))) + (((c[0] + c[1]) + (c[2] + c[3])) + ((d[0] + d[1]) + (d[2] + d[3])));
    return 1.0f / sqrtf(s * (1.0f / 1024.0f) + 1e-5f);
}
__device__ __forceinline__ float clamp8(float v) { return fminf(fmaxf(v, -448.f), 448.f); }
__device__ __forceinline__ unsigned pk4_fp8(float a, float b, float c, float d) {
    int w = __builtin_amdgcn_cvt_pk_fp8_f32(clamp8(a), clamp8(b), 0, false); w = __builtin_amdgcn_cvt_pk_fp8_f32(clamp8(c), clamp8(d), w, true); return (unsigned)w; }
__device__ __forceinline__ float silu_mul(float g, float u) { return g * u * __builtin_amdgcn_rcpf(1.0f + __builtin_amdgcn_exp2f(-1.4426950408889634f * g)); }
__device__ __forceinline__ float silu_mul_raw(float a, float b, float c1, float c3) { const float e = __builtin_amdgcn_exp2f(a * c1); return (a * b) * __builtin_amdgcn_rcpf(__builtin_fmaf(e, c3, c3)); }

struct EpiRes {
    static constexpr bool PERM = true;
    const float* xf; bf16_t* xb; float* stats; unsigned char* x8;
    __device__ __forceinline__ void operator()(const f32x4 (&acc)[2][2][4][2], const Unit& u, int wr, int wc, int fr, int fq) const {
        const size_t o0 = (size_t)(u.pm * BM + wr * 64 + fr) * 1024 + u.pn * BM + wc * 32 + 8 * fq;
#pragma unroll
        for (int ai = 0; ai < 2; ++ai) {
            if (xf) {
#pragma unroll
                for (int mp = 0; mp < 2; ++mp) { f32x4 b[2][2][2];
#pragma unroll
                    for (int mm = 0; mm < 2; ++mm)
#pragma unroll
                        for (int bj = 0; bj < 2; ++bj) { const size_t o = o0 + (size_t)(ai * HALF + (2 * mp + mm) * 16) * 1024 + bj * HALF; b[mm][bj][0] = *(const f32x4*)(xf + o); b[mm][bj][1] = *(const f32x4*)(xf + o + 4); }
#pragma unroll
                    for (int mm = 0; mm < 2; ++mm) row_out(acc, u, wr, wc, fr, fq, ai, 2 * mp + mm, o0, b[mm][0][0], b[mm][0][1], b[mm][1][0], b[mm][1][1]); }
            } else { u32x4 w[4][2];
#pragma unroll
                for (int m = 0; m < 4; ++m)
#pragma unroll
                    for (int bj = 0; bj < 2; ++bj) w[m][bj] = *(const u32x4*)(xb + o0 + (size_t)(ai * HALF + m * 16) * 1024 + bj * HALF);
#pragma unroll
                for (int m = 0; m < 4; ++m) { f32x4 b[2][2];
#pragma unroll
                    for (int bj = 0; bj < 2; ++bj) { const u32x4 p = w[m][bj];
                        b[bj][0] = (f32x4){__uint_as_float(p.x << 16), __uint_as_float(p.x & 0xffff0000u), __uint_as_float(p.y << 16), __uint_as_float(p.y & 0xffff0000u)};
                        b[bj][1] = (f32x4){__uint_as_float(p.z << 16), __uint_as_float(p.z & 0xffff0000u), __uint_as_float(p.w << 16), __uint_as_float(p.w & 0xffff0000u)}; }
                    row_out(acc, u, wr, wc, fr, fq, ai, m, o0, b[0][0], b[0][1], b[1][0], b[1][1]); }
            }
        }
    }
    __device__ __forceinline__ void row_out(const f32x4 (&acc)[2][2][4][2], const Unit& u, int wr, int wc, int fr, int fq, int ai, int m, size_t o0, f32x4 b00, f32x4 b01, f32x4 b10, f32x4 b11) const {
        const int row = u.pm * BM + ai * HALF + wr * 64 + m * 16 + fr; float ss = 0.f;
#pragma unroll
        for (int bj = 0; bj < 2; ++bj) { const size_t o = o0 + (size_t)(ai * HALF + m * 16) * 1024 + bj * HALF; const f32x4 v0 = acc[ai][bj][m][0] + (bj ? b10 : b00), v1 = acc[ai][bj][m][1] + (bj ? b11 : b01);
            ss += ((v0[0] * v0[0] + v0[1] * v0[1]) + (v0[2] * v0[2] + v0[3] * v0[3])) + ((v1[0] * v1[0] + v1[1] * v1[1]) + (v1[2] * v1[2] + v1[3] * v1[3]));
            u32x4 r; r.x = cvt_pk_bf16(v0[0], v0[1]); r.y = cvt_pk_bf16(v0[2], v0[3]); r.z = cvt_pk_bf16(v1[0], v1[1]); r.w = cvt_pk_bf16(v1[2], v1[3]);
            *(u32x4*)(xb + o) = r;
            if (x8) { uint2 p; p.x = pk4_fp8(v0[0], v0[1], v0[2], v0[3]); p.y = pk4_fp8(v1[0], v1[1], v1[2], v1[3]); *(uint2*)(x8 + o) = p; } }
        ss += __shfl_xor(ss, 16); ss += __shfl_xor(ss, 32);
        if (fq == 0) stats[(size_t)row * 16 + u.pn * 4 + wc] = ss;
    }
};
__device__ __forceinline__ void rinv8_from_stats(const float* stats, int row0  , int fq, float (&rs)[2][4]) {
    f32x4 q[2][4];
#pragma unroll
    for (int ai = 0; ai < 2; ++ai)
#pragma unroll
        for (int m = 0; m < 4; ++m) q[ai][m] = *(const f32x4*)(stats + (size_t)(row0 + ai * HALF + m * 16) * 16 + 4 * fq);
#pragma unroll
    for (int ai = 0; ai < 2; ++ai)
#pragma unroll
        for (int m = 0; m < 4; ++m) { float s = (q[ai][m][0] + q[ai][m][1]) + (q[ai][m][2] + q[ai][m][3]); s += __shfl_xor(s, 16); s += __shfl_xor(s, 32); rs[ai][m] = 1.0f / sqrtf(s * (1.0f / 1024.0f) + 1e-5f); }
}
struct EpiGU {
    static constexpr bool PERM = true;
    bf16_t* hid; int ldh; const float* stats;
    __device__ __forceinline__ void operator()(const f32x4 (&acc)[2][2][4][2], const Unit& u, int wr, int wc, int fr, int fq) const {
        float rsv[2][4]; rinv8_from_stats(stats, u.pm * BM + wr * 64 + fr, fq, rsv);
        const unsigned voff = ((unsigned)(wr * 64 + fr) * (unsigned)ldh + (unsigned)(wc * 32 + 8 * fq)) * 2u;
        char* hb = (char*)(hid + (size_t)u.pm * BM * ldh + u.pn * HALF);
#pragma unroll
        for (int ai = 0; ai < 2; ++ai)
#pragma unroll
            for (int m = 0; m < 4; ++m) { const float rs = rsv[ai][m], c1 = -1.4426950408889634f * rs, c3 = __builtin_amdgcn_rcpf(rs * rs);
                const f32x4 g0 = acc[ai][0][m][0], g1 = acc[ai][0][m][1], u0 = acc[ai][1][m][0], u1 = acc[ai][1][m][1];
                u32x4 r; r.x = cvt_pk_bf16(silu_mul_raw(g0[0], u0[0], c1, c3), silu_mul_raw(g0[1], u0[1], c1, c3)); r.y = cvt_pk_bf16(silu_mul_raw(g0[2], u0[2], c1, c3), silu_mul_raw(g0[3], u0[3], c1, c3));
                r.z = cvt_pk_bf16(silu_mul_raw(g1[0], u1[0], c1, c3), silu_mul_raw(g1[1], u1[1], c1, c3)); r.w = cvt_pk_bf16(silu_mul_raw(g1[2], u1[2], c1, c3), silu_mul_raw(g1[3], u1[3], c1, c3));
                *(u32x4*)(hb + (size_t)(ai * HALF + m * 16) * ldh * 2 + voff) = r; }
    }
};

struct EpiGU8 {
    static constexpr bool PERM = true;
    unsigned char* hid; int ldh;
    __device__ __forceinline__ void operator()(const f32x4 (&acc)[2][2][4][2], const Unit& u, int wr, int wc, int fr, int fq) const {
        const unsigned voff = (unsigned)(wr * 64 + fr) * (unsigned)ldh + (unsigned)(wc * 32 + 8 * fq);
        unsigned char* hb = hid + (size_t)u.pm * BM * ldh + u.pn * HALF;
        constexpr float c1 = -1.4426950408889634f / 2048.0f, c3 = 2048.0f * 2048.0f / 8.0f;
#pragma unroll
        for (int ai = 0; ai < 2; ++ai)
#pragma unroll
            for (int m = 0; m < 4; ++m) {
                const f32x4 g0 = acc[ai][0][m][0], g1 = acc[ai][0][m][1], u0 = acc[ai][1][m][0], u1 = acc[ai][1][m][1];
                uint2 p; p.x = pk4_fp8(silu_mul_raw(g0[0], u0[0], c1, c3), silu_mul_raw(g0[1], u0[1], c1, c3), silu_mul_raw(g0[2], u0[2], c1, c3), silu_mul_raw(g0[3], u0[3], c1, c3));
                p.y = pk4_fp8(silu_mul_raw(g1[0], u1[0], c1, c3), silu_mul_raw(g1[1], u1[1], c1, c3), silu_mul_raw(g1[2], u1[2], c1, c3), silu_mul_raw(g1[3], u1[3], c1, c3));
                *(uint2*)(hb + (size_t)(ai * HALF + m * 16) * ldh + voff) = p; }
    }
};
struct EpiQKV {
    static constexpr bool PERM = true;
    bf16_t* q; size_t tstride; const float* stats; float* nmax;
    __device__ __forceinline__ void operator()(const f32x4 (&acc)[2][2][4][2], const Unit& u, int wr, int wc, int fr, int fq) const {
        const int which = u.pn >> 2, ct = u.pn & 3; bf16_t* out = q + (size_t)which * tstride; float mx[2] = {0.f, 0.f};
        float rsv[2][4]; rinv8_from_stats(stats, u.pm * BM + wr * 64 + fr, fq, rsv);
#pragma unroll
        for (int ai = 0; ai < 2; ++ai)
#pragma unroll
            for (int m = 0; m < 4; ++m) { const int row = u.pm * BM + ai * HALF + wr * 64 + m * 16 + fr; const float rs = rsv[ai][m];
#pragma unroll
                for (int bj = 0; bj < 2; ++bj) { const f32x4 v0 = acc[ai][bj][m][0] * rs, v1 = acc[ai][bj][m][1] * rs;
                    u32x4 r; r.x = cvt_pk_bf16(v0[0], v0[1]); r.y = cvt_pk_bf16(v0[2], v0[3]); r.z = cvt_pk_bf16(v1[0], v1[1]); r.w = cvt_pk_bf16(v1[2], v1[3]);
                    *(u32x4*)(out + (size_t)row * 1024 + ct * BM + bj * HALF + wc * 32 + 8 * fq) = r;
                    if (which < 2) { float ss = ((v0[0] * v0[0] + v0[1] * v0[1]) + (v0[2] * v0[2] + v0[3] * v0[3])) + ((v1[0] * v1[0] + v1[1] * v1[1]) + (v1[2] * v1[2] + v1[3] * v1[3]));
                        ss += __shfl_xor(ss, 16); ss += __shfl_xor(ss, 32); mx[bj] = fmaxf(mx[bj], ss); } } }
        if (which < 2) {
#pragma unroll
            for (int bj = 0; bj < 2; ++bj) { float v = mx[bj]; v = fmaxf(v, __shfl_xor(v, 1)); v = fmaxf(v, __shfl_xor(v, 2)); v = fmaxf(v, __shfl_xor(v, 4)); v = fmaxf(v, __shfl_xor(v, 8));
                if (fr == 0 && fq == 0) nmax[(((size_t)which * 128 + u.pm) * 16 + ct * 4 + bj * 2 + (wc >> 1)) * 4 + 2 * (wc & 1) + wr] = v; }
        }
    }
};

struct EpiMoeD {
    static constexpr bool PERM = true;
    bf16_t* y; const int2* slotinfo; float scale;
    __device__ __forceinline__ void operator()(const f32x4 (&acc)[2][2][4][2], const Unit& u, int wr, int wc, int fr, int fq) const {
        int fr_ = fr; asm volatile("" : "+v"(fr_), "+v"(fq));
        int2 siv[2][4];
#pragma unroll
        for (int ai = 0; ai < 2; ++ai)
#pragma unroll
            for (int m = 0; m < 4; ++m) siv[ai][m] = slotinfo[u.pm * BM + ai * HALF + wr * 64 + m * 16 + fr_];
#pragma unroll
        for (int ai = 0; ai < 2; ++ai)
#pragma unroll
            for (int m = 0; m < 4; ++m) { const int2 si = siv[ai][m];
                if (si.x >= 0) { const float w = __int_as_float(si.y) * scale;
#pragma unroll
                    for (int bj = 0; bj < 2; ++bj) { const size_t o = (size_t)si.x * 1024 + u.pn * BM + bj * HALF + wc * 32 + 8 * fq; const f32x4 v0 = acc[ai][bj][m][0] * w, v1 = acc[ai][bj][m][1] * w;
                        u32x4 r; r.x = cvt_pk_bf16(v0[0], v0[1]); r.y = cvt_pk_bf16(v0[2], v0[3]); r.z = cvt_pk_bf16(v1[0], v1[1]); r.w = cvt_pk_bf16(v1[2], v1[3]);
                        *(u32x4*)(y + o) = r; } } }
    }
};

typedef int v4i_t __attribute__((ext_vector_type(4)));
typedef int v8i_t __attribute__((ext_vector_type(8)));
__device__ __forceinline__ void glds16_sv(const void* sbase, unsigned voff, unsigned lds_dst) { unsigned keep;
    asm volatile("s_mov_b32 %0, m0\n\ts_mov_b32 m0, %3\n\ts_nop 0\n\tglobal_load_lds_dwordx4 %1, %2\n\ts_mov_b32 m0, %0" : "=&s"(keep) : "v"(voff), "s"(sbase), "s"(lds_dst) : "memory"); }
template <class Epi, class Sched, bool ALIGN_EPI, int ESZ = 2, bool PEEL_A = true, bool PEEL_B = true>
__device__ __forceinline__ void gemm_phase(PG8_LAS unsigned char* lds, const Gemm g, const Sched& S, const Epi& E) {
    const int wid = __builtin_amdgcn_readfirstlane((int)threadIdx.x >> 6); int lane = lane_id(); asm volatile("" : "+v"(lane));
    const int tid = wid * 64 + lane; const int wr = wid >> 2, wc = wid & 3, fr = lane & 15, fq = lane >> 4;
    const int K = g.K, nt = K * ESZ / (BK * 2);
    const unsigned lda2 = (unsigned)g.lda * (unsigned)ESZ, ldb2 = (unsigned)g.ldb * (unsigned)ESZ;
    unsigned voffB[2], CA[2]; int RA[2];
#pragma unroll
    for (int i = 0; i < 2; ++i) { int R, C; stage_rc(tid * 16 + i * 8192, R, C); const int Rb = Epi::PERM ? ((R & ~31) + perm32(R & 31)) : R;
        RA[i] = R; CA[i] = (unsigned)C * 2u; voffB[i] = (unsigned)Rb * ldb2 + (unsigned)C * 2u; }
    const size_t kstep = (size_t)(BK * 2);
    const size_t hstepB = (size_t)HALF * ldb2;
    const unsigned ldsw = (unsigned)wid * 1024u;
    const int aoff = lds_byte(wr * 64 + fr, fq * 8), boff = lds_byte(wc * 32 + fr, fq * 8);
    const PG8_LAS unsigned char* abase = lds + aoff; const PG8_LAS unsigned char* bbase = lds + 4 * HTB + boff; asm volatile("" : "+v"(abase), "+v"(bbase));
    const unsigned ldsbase = (unsigned)__builtin_amdgcn_readfirstlane((int)((unsigned)(size_t)lds + ldsw));
#define PG8_OFFS(o, u) do { _Pragma("unroll") for (int _h = 0; _h < 2; ++_h) _Pragma("unroll") for (int _i = 0; _i < 2; ++_i) \
        (o)[_h][_i] = (Sched::GATHER ? (unsigned)S.tok((u).pm * BM + _h * HALF + RA[_i]) : (unsigned)(_h * HALF + RA[_i])) * lda2 + CA[_i]; } while (0)
#define PG8_SA(b, h) (((b) * 2 + (h)) * HTB)
#define PG8_SB(b, h) ((4 + (b) * 2 + (h)) * HTB)
#define PG8_STAGE(bufoff, gbase, voff) do { _Pragma("unroll") for (int _i = 0; _i < 2; ++_i) \
        glds16_sv((const char*)(gbase), (voff)[_i], ldsbase + (unsigned)((bufoff) + _i * 8192)); } while (0)
#define PG8_LD32(base, off) __builtin_shufflevector(*(const PG8_LAS v4i_t*)((base) + (off)), *(const PG8_LAS v4i_t*)((base) + (off) + 1024), 0, 1, 2, 3, 4, 5, 6, 7)
#define PG8_LDA(dst, b, h) do { if constexpr (ESZ == 2) { _Pragma("unroll") for (int m = 0; m < 4; ++m) _Pragma("unroll") for (int k = 0; k < 2; ++k) dst[m][k] = *(const PG8_LAS bf16x8*)(abase + PG8_SA(b, h) + m * 2048 + k * 1024); } \
      else { _Pragma("unroll") for (int m = 0; m < 4; ++m) dst##8[m] = PG8_LD32(abase, PG8_SA(b, h) + m * 2048); } } while (0)
#define PG8_LDB(dst, b, h) do { if constexpr (ESZ == 2) { _Pragma("unroll") for (int n = 0; n < 2; ++n) _Pragma("unroll") for (int k = 0; k < 2; ++k) dst[n][k] = *(const PG8_LAS bf16x8*)(bbase + (PG8_SB(b, h) - 4 * HTB) + n * 2048 + k * 1024); } \
      else { _Pragma("unroll") for (int n = 0; n < 2; ++n) dst##8[n] = PG8_LD32(bbase, (PG8_SB(b, h) - 4 * HTB) + n * 2048); } } while (0)
#define PG8_CAT(x, y) __builtin_shufflevector(__builtin_bit_cast(v4i_t, x), __builtin_bit_cast(v4i_t, y), 0, 1, 2, 3, 4, 5, 6, 7)
#define PG8_MMA(ai, bj, At, Bt, Z) do { __builtin_amdgcn_s_setprio(1); if constexpr (ESZ == 2) { _Pragma("unroll") for (int m = 0; m < 4; ++m) _Pragma("unroll") for (int n = 0; n < 2; ++n) _Pragma("unroll") for (int k = 0; k < 2; ++k) \
        acc[ai][bj][m][n] = __builtin_amdgcn_mfma_f32_16x16x32_bf16(Bt[n][k], At[m][k], ((Z) && k == 0) ? (f32x4){0.f, 0.f, 0.f, 0.f} : acc[ai][bj][m][n], 0, 0, 0); } \
      else { _Pragma("unroll") for (int m = 0; m < 4; ++m) _Pragma("unroll") for (int n = 0; n < 2; ++n) \
        acc[ai][bj][m][n] = __builtin_amdgcn_mfma_scale_f32_16x16x128_f8f6f4(Bt##8[n], At##8[m], (Z) ? (f32x4){0.f, 0.f, 0.f, 0.f} : acc[ai][bj][m][n], 0, 0, 0, 0x7f7f7f7f, 0, 0x7f7f7f7f); } \
      __builtin_amdgcn_s_setprio(0); } while (0)
#define PG8_WAIT_V(n) asm volatile("s_waitcnt vmcnt(" #n ")" ::: "memory")
#define PG8_WAIT_L(n) asm volatile("s_waitcnt lgkmcnt(" #n ")" ::: "memory")
#define PG8_BAR __builtin_amdgcn_s_barrier()
#define PG8_SCHED __builtin_amdgcn_sched_barrier(0)
    Unit cur, nxt; int ui = 0;
    if (!S.next(0, cur)) return;
    f32x4 acc[2][2][4][2];
    bf16x8 At[4][2], B0[2][2], B1[2][2]; v8i_t At8[4], B08[2], B18[2];
    unsigned offc[2][2];
    PG8_LAS u32x4* stash = (PG8_LAS u32x4*)(lds + STAGE_BYTES) + tid;
    PG8_OFFS(offc, cur);
    const char* cA = (const char*)g.A + cur.aoff; const char* cB = (const char*)g.Bt + cur.boff;
    PG8_STAGE(PG8_SB(0, 0), cB, voffB); PG8_STAGE(PG8_SB(0, 1), cB + hstepB, voffB); PG8_STAGE(PG8_SA(0, 0), cA, offc[0]); PG8_STAGE(PG8_SA(0, 1), cA, offc[1]);
    if (wr == 1) PG8_BAR;
    PG8_WAIT_V(2); PG8_BAR;
    PG8_STAGE(PG8_SB(1, 0), cB + kstep, voffB); PG8_STAGE(PG8_SA(1, 0), cA + kstep, offc[0]); PG8_STAGE(PG8_SB(1, 1), cB + hstepB + kstep, voffB);
    PG8_WAIT_V(6); PG8_BAR;
    for (;;) {
        const bool has_next = S.next(ui + 1, nxt);
        if constexpr (Sched::GATHER) { if (has_next) { unsigned t_[2][2]; PG8_OFFS(t_, nxt); *stash = (u32x4){t_[0][0], t_[0][1], t_[1][0], t_[1][1]}; } }
        const char* nA = has_next ? (const char*)g.A + nxt.aoff : cA; const char* nB = has_next ? (const char*)g.Bt + nxt.boff : cB;
#define PG8_KBODY(ZF, ZG) do { \
            const bool last = ((ZF) || (ZG)) ? false : (t == nt - 2); \
            const char* a1 = cA + (size_t)(t + 1) * kstep; \
            const char* a2 = last ? nA : cA + (size_t)(t + 2) * kstep; const char* b2 = last ? nB : cB + (size_t)(t + 2) * kstep; \
            const char* a3 = a2 + kstep; const char* b3 = b2 + kstep; \
            unsigned o2[2][2]; \
_Pragma("unroll") \
            for (int h = 0; h < 2; ++h) \
_Pragma("unroll") \
                for (int i = 0; i < 2; ++i) o2[h][i] = offc[h][i]; \
            if constexpr (Sched::GATHER) { if (last && has_next) { const u32x4 s_ = *stash; o2[0][0] = s_[0]; o2[0][1] = s_[1]; o2[1][0] = s_[2]; o2[1][1] = s_[3]; } } \
 \
 \
            PG8_LDB(B0, 0, 0); PG8_LDB(B1, 0, 1); PG8_SCHED; PG8_LDA(At, 0, 0); PG8_STAGE(PG8_SA(1, 1), a1, offc[1]); \
            PG8_WAIT_V(8); PG8_WAIT_L(0); PG8_BAR; PG8_SCHED; PG8_MMA(0, 0, At, B0, ZF); PG8_MMA(0, 1, At, B1, ZF); PG8_SCHED; PG8_BAR; PG8_SCHED; \
 \
            PG8_LDA(At, 0, 1); PG8_STAGE(PG8_SB(0, 0), b2, voffB); PG8_STAGE(PG8_SB(0, 1), b2 + hstepB, voffB); PG8_STAGE(PG8_SA(0, 0), a2, o2[0]); \
            PG8_WAIT_V(8); PG8_WAIT_L(0); PG8_BAR; PG8_SCHED; PG8_MMA(1, 0, At, B0, ZG); PG8_MMA(1, 1, At, B1, ZG); PG8_SCHED; PG8_BAR; PG8_SCHED; \
 \
            PG8_LDB(B0, 1, 0); PG8_LDB(B1, 1, 1); PG8_SCHED; PG8_LDA(At, 1, 0); PG8_STAGE(PG8_SA(0, 1), a2, o2[1]); \
            PG8_WAIT_V(8); PG8_WAIT_L(0); PG8_BAR; PG8_SCHED; PG8_MMA(0, 0, At, B0, false); PG8_MMA(0, 1, At, B1, false); PG8_SCHED; PG8_BAR; PG8_SCHED; \
 \
            PG8_LDA(At, 1, 1); PG8_STAGE(PG8_SB(1, 0), b3, voffB); PG8_STAGE(PG8_SB(1, 1), b3 + hstepB, voffB); PG8_STAGE(PG8_SA(1, 0), a3, o2[0]); \
            PG8_WAIT_V(8); PG8_WAIT_L(0); PG8_BAR; PG8_SCHED; PG8_MMA(1, 0, At, B0, false); PG8_MMA(1, 1, At, B1, false); PG8_SCHED; PG8_BAR; PG8_SCHED; \
        } while (0)
        constexpr bool ZA = PEEL_A, ZB = PEEL_B;
#define PG8_ZERO4(x) do { f32x2 lo_, hi_; asm volatile("v_mov_b64 %0, 0" : "=v"(lo_)); asm volatile("v_mov_b64 %0, 0" : "=v"(hi_)); (x) = (f32x4){lo_[0], lo_[1], hi_[0], hi_[1]}; } while (0)
        if constexpr (!ZA) {
#pragma unroll
            for (int b = 0; b < 2; ++b)
#pragma unroll
                for (int m = 0; m < 4; ++m)
#pragma unroll
                    for (int n = 0; n < 2; ++n) PG8_ZERO4(acc[0][b][m][n]); }
        if constexpr (!ZB) {
#pragma unroll
            for (int b = 0; b < 2; ++b)
#pragma unroll
                for (int m = 0; m < 4; ++m)
#pragma unroll
                    for (int n = 0; n < 2; ++n) PG8_ZERO4(acc[1][b][m][n]); }
#undef PG8_ZERO4
        if constexpr (ZA || ZB) { const int t = 0; PG8_KBODY(ZA, ZB); }
#pragma nounroll
        for (int t = (ZA || ZB) ? 2 : 0; t < nt; t += 2) { PG8_KBODY(false, false); }
#undef PG8_KBODY
        if constexpr (ALIGN_EPI) { if (wr == 0) PG8_BAR; }
        E(acc, cur, wr, wc, fr, fq);
        if (!has_next) break;
        cur = nxt; cA = nA; cB = nB; ++ui;
        if constexpr (Sched::GATHER) { const u32x4 s_ = *stash; offc[0][0] = s_[0]; offc[0][1] = s_[1]; offc[1][0] = s_[2]; offc[1][1] = s_[3]; }
        if constexpr (ALIGN_EPI) { if (wr == 1) PG8_BAR; }
    }
    PG8_WAIT_V(0);
    if constexpr (!ALIGN_EPI) { if (wr == 0) PG8_BAR; }
    PG8_BAR;
#undef PG8_OFFS
#undef PG8_SA
#undef PG8_SB
#undef PG8_STAGE
#undef PG8_LDA
#undef PG8_LD32
#undef PG8_LDB
#undef PG8_MMA
#undef PG8_CAT
#undef PG8_WAIT_V
#undef PG8_WAIT_L
#undef PG8_BAR
#undef PG8_SCHED
}
}
constexpr int CONV_ITEMS_PER_UNIT = 48, N_CONV_ALL = (NE * (2 * 16 * (FFE / 64) + (FFE / 64) * 16)) / CONV_ITEMS_PER_UNIT;
constexpr int CONV_P4 = 128, N_CONV_UNITS = N_CONV_ALL - CONV_P4;
__device__ __forceinline__ void expert_conv_unit(unsigned char* ws, int cu, __attribute__((address_space(3))) unsigned char* lds);
#include <hip/hip_bf16.h>
#include <cmath>
namespace attn_body {
using bf16=__hip_bfloat16;
using bf16x8=__attribute__((ext_vector_type(8)))short;
using s16x4=__attribute__((ext_vector_type(4)))short;
using f32x16=__attribute__((ext_vector_type(16)))float;
using u32x4=__attribute__((ext_vector_type(4)))unsigned;
constexpr int BATCH=2,NHEAD=16,SEQ=16384,D=64,DM=NHEAD*D;
constexpr int NW=8,QBLK=32,QB=QBLK*NW,KVBLK=64,NQB=SEQ/QB;
constexpr int ATTN_PITCH=DM, ATTN_UNIT_ROWS=QB;
__device__ __forceinline__ int crow(int r,int hi){return (r&3)+8*(r>>2)+4*hi;}
#define SBAR() __builtin_amdgcn_sched_barrier(0)
__device__ __forceinline__ void cmask(f32x16&p0,f32x16&p1,int jb,int qrel,int hi){
  const float NEG=-INFINITY; int kb=64*jb+4*hi;
  #pragma unroll
  for(int r=0;r<16;++r){int kv=kb+(r&3)+8*(r>>2); if(kv>qrel)p0[r]=NEG; if(kv+32>qrel)p1[r]=NEG;}
}

constexpr int NSLOT=3, SLOTB=8192;
constexpr int LDS_K=0, LDS_V=NSLOT*SLOTB, LDS_WS=2*NSLOT*SLOTB, LDS_OST=LDS_WS+NW*64*4, LDS_BYTES=LDS_OST+NW*4096;
constexpr float C2=0.125f*1.4426950408889634f;
__device__ __forceinline__ void glds16s(const void*sbase,unsigned voff,unsigned lds_dst){unsigned keep;
  asm volatile("s_mov_b32 %0, m0\n\ts_mov_b32 m0, %3\n\ts_nop 0\n\tglobal_load_lds_dwordx4 %1, %2\n\ts_mov_b32 m0, %0":"=&s"(keep):"v"(voff),"s"(sbase),"s"(lds_dst):"memory");}
__device__ __forceinline__ void glds16(const void*gsrc,unsigned lds_dst){unsigned keep;
  asm volatile("s_mov_b32 %0, m0\n\ts_mov_b32 m0, %2\n\ts_nop 0\n\tglobal_load_lds_dwordx4 %1, off\n\ts_mov_b32 m0, %0":"=&s"(keep):"v"(gsrc),"s"(lds_dst):"memory");}
__device__ __forceinline__ float max3f(float a,float b,float c){float r;asm("v_max3_f32 %0, %1, %2, %3":"=v"(r):"v"(a),"v"(b),"v"(c));return r;}
__device__ __forceinline__ float max2f(float a,float b){float r;asm("v_max_f32_e32 %0, %1, %2":"=v"(r):"v"(a),"v"(b));return r;}
__device__ __forceinline__ float fadd_s(float a,float b){float r;asm("v_add_f32_e32 %0, %1, %2":"=v"(r):"v"(a),"v"(b));return r;}
__device__ __forceinline__ float fsub_s(float a,float b){float r;asm("v_sub_f32_e32 %0, %1, %2":"=v"(r):"v"(a),"v"(b));return r;}
typedef float f32x2_t __attribute__((ext_vector_type(2))); typedef __bf16 bf16x2_t __attribute__((ext_vector_type(2)));
__device__ __forceinline__ unsigned cvtpk_s(float lo,float hi){f32x2_t v={lo,hi};bf16x2_t b=__builtin_convertvector(v,bf16x2_t);return __builtin_bit_cast(unsigned,b);}
#define WAIT_BAR(N) asm volatile("s_waitcnt vmcnt(" #N ") lgkmcnt(0)\n\ts_barrier":::"memory")

__device__ __forceinline__ void qkt(f32x16&p0,f32x16&p1,const char*Kslot,const bf16x8*qr,bf16x8 kxa,bf16x8 kxb,bf16x8 qx,int r32,int hi){
  p0=__builtin_amdgcn_mfma_f32_32x32x16_bf16(kxa,qx,f32x16{},0,0,0);p1=__builtin_amdgcn_mfma_f32_32x32x16_bf16(kxb,qx,f32x16{},0,0,0);
  const char*kb=Kslot+hi*1024+r32*16;
  #pragma unroll
  for(int d0=0;d0<4;++d0){
    const bf16x8 b0=*reinterpret_cast<const bf16x8*>(kb+d0*2048);
    const bf16x8 b1=*reinterpret_cast<const bf16x8*>(kb+d0*2048+512);
    p0=__builtin_amdgcn_mfma_f32_32x32x16_bf16(b0,qr[d0],p0,0,0,0);p1=__builtin_amdgcn_mfma_f32_32x32x16_bf16(b1,qr[d0],p1,0,0,0);}
}
typedef __attribute__((address_space(3))) const char* lds_cptr;
typedef short v4i16_t __attribute__((ext_vector_type(4)));
__device__ __forceinline__ void kload8(bf16x8*kf,lds_cptr kp){
  kf[0]=*(const __attribute__((address_space(3))) bf16x8*)(kp);      kf[1]=*(const __attribute__((address_space(3))) bf16x8*)(kp+512);
  kf[2]=*(const __attribute__((address_space(3))) bf16x8*)(kp+2048); kf[3]=*(const __attribute__((address_space(3))) bf16x8*)(kp+2560);
  kf[4]=*(const __attribute__((address_space(3))) bf16x8*)(kp+4096); kf[5]=*(const __attribute__((address_space(3))) bf16x8*)(kp+4608);
  kf[6]=*(const __attribute__((address_space(3))) bf16x8*)(kp+6144); kf[7]=*(const __attribute__((address_space(3))) bf16x8*)(kp+6656);
}
__device__ __forceinline__ void kload2(bf16x8*kf,lds_cptr kp,int j){ kf[2*j]=*(const __attribute__((address_space(3))) bf16x8*)(kp+j*2048); kf[2*j+1]=*(const __attribute__((address_space(3))) bf16x8*)(kp+j*2048+512); }
__device__ __forceinline__ s16x4 vtr(lds_cptr p){ return __builtin_bit_cast(s16x4,__builtin_amdgcn_ds_read_tr16_b64_v4i16((__attribute__((address_space(3))) v4i16_t*)p)); }
__device__ __forceinline__ float rowmax(const f32x16&p0,const f32x16&p1){
  float a=max3f(p0[0],p0[1],p1[0]),b=max3f(p0[2],p0[3],p1[1]);a=max3f(a,p1[2],p1[3]);
  #pragma unroll
  for(int r=4;r<16;r+=4){a=max3f(a,p0[r],p0[r+1]);b=max3f(b,p0[r+2],p0[r+3]);a=max3f(a,p1[r],p1[r+1]);b=max3f(b,p1[r+2],p1[r+3]);}
  const float m=max2f(a,b);
  auto rr=__builtin_amdgcn_permlane32_swap(__float_as_uint(m),__float_as_uint(m),false,false);
  return max2f(__uint_as_float(rr[0]),__uint_as_float(rr[1]));
}
__device__ __forceinline__ void pv(f32x16*o,int vb,bf16x8 pa0,bf16x8 pa1,bf16x8 pa2,bf16x8 pa3){
  #pragma unroll
  for(int d0=0;d0<2;++d0){s16x4 lo[4],hi[4];
    #pragma unroll
    for(int ks=0;ks<4;++ks){
      asm volatile("ds_read_b64_tr_b16 %0,%1 offset:%c2":"=&v"(lo[ks]):"v"(vb),"i"(d0*4096+ks*1024):"memory");
      asm volatile("ds_read_b64_tr_b16 %0,%1 offset:%c2":"=&v"(hi[ks]):"v"(vb),"i"(d0*4096+ks*1024+512):"memory");}
    asm volatile("s_waitcnt lgkmcnt(0)":::"memory");SBAR();
    #define PK(k) (bf16x8){lo[k][0],lo[k][1],lo[k][2],lo[k][3],hi[k][0],hi[k][1],hi[k][2],hi[k][3]}
    o[d0]=__builtin_amdgcn_mfma_f32_32x32x16_bf16(pa0,PK(0),o[d0],0,0,0);
    o[d0]=__builtin_amdgcn_mfma_f32_32x32x16_bf16(pa1,PK(1),o[d0],0,0,0);
    o[d0]=__builtin_amdgcn_mfma_f32_32x32x16_bf16(pa2,PK(2),o[d0],0,0,0);
    o[d0]=__builtin_amdgcn_mfma_f32_32x32x16_bf16(pa3,PK(3),o[d0],0,0,0);
    #undef PK
  }
}

__device__ __forceinline__ void split3(float g,unsigned&h,unsigned&m,unsigned&l){ h=__float_as_uint(g)&0xffff0000u; const float r1=g-__uint_as_float(h); m=__float_as_uint(r1)&0xffff0000u; const float r2=r1-__uint_as_float(m); l=__float_as_uint(r2)&0xffff0000u; }
__device__ __forceinline__ float rndbf(float x){ const unsigned u=__float_as_uint(x); return __uint_as_float((u+0x7fffu+((u>>16)&1u))&0xffff0000u); }
typedef __attribute__((address_space(3))) const float* lds_fptr;
#ifndef ATTN_STORE16
#define ATTN_STORE16(p,v) (*(u32x4*)(p)=(v))
#endif
template<int THRL> __device__ __forceinline__ void attn_unit(int b,int h,int qb,int t0,const bf16*Q,const bf16*__restrict__ K,const bf16*__restrict__ V,bf16*O,char*shm,lds_fptr gwp,lds_fptr offs){
  int tid=threadIdx.x; asm volatile("":"+v"(tid)); const int lane=tid&63,r32=lane&31,hi=lane>>5; const int wid=__builtin_amdgcn_readfirstlane(tid>>6);
  const long rowbase=(long)b*SEQ; const int q0=qb*QB;
  const bf16*Qw=Q+(rowbase+q0+wid*QBLK)*DM+h*D;
  const bf16*Kh=K+(rowbase+(long)t0*KVBLK)*DM+h*D,*Vh=V+(rowbase+(long)t0*KVBLK)*DM+h*D;
  const unsigned lds0=(unsigned)(uintptr_t)shm;
  float*wsf=(float*)(shm+LDS_WS)+wid*64;
  const unsigned koff=(unsigned)(lane*DM+wid*8)*2u;
  const unsigned voff=(unsigned)((16*(wid&3)+(lane>>2))*DM+(wid>>2)*32+(lane&3)*8)*2u;
  const unsigned kdst=lds0+LDS_K+wid*1024, vdst=lds0+LDS_V+wid*1024;
  #define DMA_K(t,slot) glds16s(Kh+(long)(t)*KVBLK*DM,koff,(unsigned)__builtin_amdgcn_readfirstlane(kdst+(slot)))
  #define DMA_V(t,slot) glds16s(Vh+(long)(t)*KVBLK*DM,voff,(unsigned)__builtin_amdgcn_readfirstlane(vdst+(slot)))
  const int vb0=(int)(lds0+LDS_V)+((lane>>4)&1)*32+(lane&3)*8+(4*hi+((lane&15)>>2))*64;
  const char*Kbase=shm+LDS_K; bf16x8 kf[8];
  const lds_cptr shm3=(lds_cptr)shm; const lds_cptr kp0=shm3+LDS_K+hi*1024+r32*16; const lds_cptr vp0=shm3+LDS_V+((lane>>4)&1)*32+(lane&3)*8+(4*hi+((lane&15)>>2))*64;
  const int NT=(q0+QB)/KVBLK-t0;
  DMA_K(0,0);DMA_V(0,0);DMA_K(1,SLOTB);
  bf16x8 qr[4];
  #pragma unroll
  for(int d0=0;d0<4;++d0)qr[d0]=*reinterpret_cast<const bf16x8*>(&Qw[(long)r32*DM+d0*16+hi*8]);
  const lds_cptr qst=shm3+LDS_OST+wid*4096+lane*16;
  *(__attribute__((address_space(3))) bf16x8*)(qst)=qr[2]; *(__attribute__((address_space(3))) bf16x8*)(qst+1024)=qr[3];
  #define QLD(j) (*(const __attribute__((address_space(3))) bf16x8*)(qst+((j)-2)*1024))
  float mhat=0.f,l_reg=0.f;f32x16 o[2];o[0]=f32x16{};o[1]=f32x16{};
  #define HM(x) (hi?0u:(x))
  u32x4 kxa,kxb,qxv; kxa[0]=HM(0x3F803F80u);kxa[3]=HM(0x00003F80u);kxb[0]=kxa[0];kxb[3]=kxa[3];
  float ga_,gb_;
  #define KXLOAD(T) do{ const float o_=offs[(T)]; ga_=gwp[(T)*KVBLK+r32]+o_; gb_=gwp[(T)*KVBLK+32+r32]+o_; }while(0)
  #define KXMAKE() do{ unsigned h_,m_,l_; split3(ga_,h_,m_,l_); kxa[1]=HM(0x3F80u|(h_^0x80000000u)); kxa[2]=HM(((m_^0x80000000u)>>16)|(l_^0x80000000u)); \
      split3(gb_,h_,m_,l_); kxb[1]=HM(0x3F80u|(h_^0x80000000u)); kxb[2]=HM(((m_^0x80000000u)>>16)|(l_^0x80000000u)); }while(0)
  #define KXA __builtin_bit_cast(bf16x8,kxa)
  #define KXB __builtin_bit_cast(bf16x8,kxb)
  #define QXV __builtin_bit_cast(bf16x8,qxv)
  const int qrel=wid*QBLK+r32;
  #define CMASK(P0,P1,t) do{int jb_=(t)-(NT-4); if(jb_>=0)cmask(P0,P1,jb_,qrel,hi);}while(0)
  bool resc=false;
  #define START(P0,P1) do{ const float rm=rowmax(P0,P1); resc=false; \
    { const float dl=rndbf(rm); mhat=dl; \
      _Pragma("unroll") for(int r=0;r<16;++r){P0[r]=fsub_s(P0[r],dl);P1[r]=fsub_s(P1[r],dl);} \
      qxv[3]=HM(__float_as_uint(-mhat)>>16); } \
    _Pragma("unroll") for(int r=0;r<16;++r)P0[r]=__builtin_amdgcn_exp2f(P0[r]); }while(0)
  #define RESC() do{ if(resc){ asm volatile("s_waitcnt lgkmcnt(0)":::"memory"); \
      _Pragma("unroll") for(int d_=0;d_<2;++d_) _Pragma("unroll") for(int r=0;r<16;++r)o[d_][r]*=wsf[crow(r,hi)]; } }while(0)
  f32x16 pA0,pA1,pB0,pB1;
  int sl_prev=0,sl_cur=0,sl_next=SLOTB;
  #define ROT() do{sl_prev=sl_cur;sl_cur=sl_next;sl_next=(sl_next==(NSLOT-1)*SLOTB)?0:sl_next+SLOTB;}while(0)
  DMA_K(2,2*SLOTB);
  WAIT_BAR(3);
  { unsigned h_,m_,l_; split3(gwp[q0-t0*KVBLK+wid*QBLK+r32]+offs[q0/KVBLK-t0+(wid>>1)],h_,m_,l_); qxv[0]=HM((h_>>16)|m_); qxv[1]=HM((l_>>16)|0x3F800000u); qxv[2]=kxa[0]; qxv[3]=0u; }
  KXLOAD(0); KXMAKE();
  qkt(pA0,pA1,Kbase,qr,KXA,KXB,QXV,r32,hi);asm volatile("s_nop 15\n\ts_nop 7":"+v"(pA0),"+v"(pA1));CMASK(pA0,pA1,0);
  START(pA0,pA1);
  _Pragma("unroll") for(int r=0;r<16;++r)pA1[r]=__builtin_amdgcn_exp2f(pA1[r]);
  KXLOAD(1); KXMAKE();
  WAIT_BAR(0);
  DMA_K(3,0);DMA_V(1,SLOTB);
  ROT();
  kload8(kf,kp0+sl_cur);
  WAIT_BAR(2);
  s16x4 vlo[8],vhi[8]; u32x4 pw0,pw1,pw2,pw3;
  #define PKW(P,B) cvtpk_s(P[B],P[B+1])
  #define PAF(k) __builtin_bit_cast(bf16x8,pw##k)
  #define VFR(i) (bf16x8){vlo[i][0],vlo[i][1],vlo[i][2],vlo[i][3],vhi[i][0],vhi[i][1],vhi[i][2],vhi[i][3]}
  #define PIN(x) asm volatile("":"+v"(x))
  #define MX3(a,b,c) __builtin_fmaxf(__builtin_fmaxf((a),(b)),(c))
  #define GAPA(MF,A0,A1,A2,A3,W0,W1,PW) do{ MF; sacc+=A0; sacc+=A1; sacc+=A2; sacc+=A3; PIN(sacc); W0; W1; PIN(PW); SBAR(); }while(0)
  #define EX(v) __builtin_amdgcn_exp2f(v)
  #define GAPB(MF,X,B) do{ MF; X[B]=EX(X[B]); X[B+1]=EX(X[B+1]); X[B+2]=EX(X[B+2]); X[B+3]=EX(X[B+3]); PIN(X); SBAR(); }while(0)
  #define VRD(i) do{ vlo[i]=vtr(vp_+(((i)>>2)*4096+((i)&3)*1024)); vhi[i]=vtr(vp_+(((i)>>2)*4096+((i)&3)*1024+512)); }while(0)
  #define KRD(G,j) do{ if(G){ kload2(kf,kp0+sl_next,j); SBAR(); } }while(0)
  #define STEP(C0,C1,P0,P1,t,GK,GV,GL) do{ SBAR(); \
    const lds_cptr vp_=vp0+sl_prev; \
    C0=__builtin_amdgcn_mfma_f32_32x32x16_bf16(KXA,QXV,f32x16{},0,0,0); C1=__builtin_amdgcn_mfma_f32_32x32x16_bf16(KXB,QXV,f32x16{},0,0,0); SBAR(); \
    VRD(0); SBAR(); float sacc=(P0[0]+P0[1]); \
    GAPA(C0=__builtin_amdgcn_mfma_f32_32x32x16_bf16(kf[0],qr[0],C0,0,0,0), P0[2],P0[3],P0[4],P0[5],     pw0[0]=PKW(P0,0), pw0[1]=PKW(P0,2), pw0); \
    VRD(4); SBAR(); GAPA(C1=__builtin_amdgcn_mfma_f32_32x32x16_bf16(kf[1],qr[0],C1,0,0,0), P0[6],P0[7],P0[8],P0[9],     pw0[2]=PKW(P0,4), pw0[3]=PKW(P0,6), pw0); \
    VRD(1); const bf16x8 q2_=QLD(2); SBAR(); GAPA(C0=__builtin_amdgcn_mfma_f32_32x32x16_bf16(kf[2],qr[1],C0,0,0,0),   P0[10],P0[11],P0[12],P0[13], pw1[0]=PKW(P0,8), pw1[1]=PKW(P0,10), pw1); \
    VRD(5); SBAR(); GAPA(C1=__builtin_amdgcn_mfma_f32_32x32x16_bf16(kf[3],qr[1],C1,0,0,0),   P0[14],P0[15],P1[0],P1[1],   pw1[2]=PKW(P0,12),pw1[3]=PKW(P0,14), pw1); \
    VRD(2); const bf16x8 q3_=QLD(3); SBAR(); GAPA(C0=__builtin_amdgcn_mfma_f32_32x32x16_bf16(kf[4],q2_,C0,0,0,0),   P1[2],P1[3],P1[4],P1[5],     pw2[0]=PKW(P1,0), pw2[1]=PKW(P1,2), pw2); \
    VRD(6); SBAR(); GAPA(C1=__builtin_amdgcn_mfma_f32_32x32x16_bf16(kf[5],q2_,C1,0,0,0),   P1[6],P1[7],P1[8],P1[9],     pw2[2]=PKW(P1,4), pw2[3]=PKW(P1,6), pw2); \
    VRD(3); SBAR(); GAPA(C0=__builtin_amdgcn_mfma_f32_32x32x16_bf16(kf[6],q3_,C0,0,0,0),   P1[10],P1[11],P1[12],P1[13], pw3[0]=PKW(P1,8), pw3[1]=PKW(P1,10), pw3); \
    VRD(7); SBAR(); GAPA(C1=__builtin_amdgcn_mfma_f32_32x32x16_bf16(kf[7],q3_,C1,0,0,0),   P1[14],P1[15],0.f,0.f,       pw3[2]=PKW(P1,12),pw3[3]=PKW(P1,14), pw3); \
    l_reg+=sacc; \
    if(GK){DMA_K((t)+3,sl_cur);} if(GV){DMA_V((t)+1,sl_next);} \
    CMASK(C0,C1,t); \
    { float a=MX3(C0[0],C0[1],C1[0]),b=MX3(C0[2],C0[3],C1[1]); a=MX3(a,C1[2],C1[3]); \
      _Pragma("unroll") for(int r=4;r<16;r+=4){a=MX3(a,C0[r],C0[r+1]);b=MX3(b,C0[r+2],C0[r+3]);a=MX3(a,C1[r],C1[r+1]);b=MX3(b,C1[r+2],C1[r+3]);} \
      float rm=__builtin_fmaxf(a,b); { auto rr=__builtin_amdgcn_permlane32_swap(__float_as_uint(rm),__float_as_uint(rm),false,false); rm=__builtin_fmaxf(__uint_as_float(rr[0]),__uint_as_float(rr[1])); } \
      resc=false; \
      if(__builtin_expect(__any(rm>(float)THRL),0)){ const float mn_=rndbf(mhat+__builtin_fmaxf(rm,0.f)); const float dl=mn_-mhat; mhat=mn_; \
        _Pragma("unroll") for(int r=0;r<16;++r){C0[r]-=dl;C1[r]-=dl;} \
        qxv[3]=HM(__float_as_uint(-mhat)>>16); \
        const float f=__builtin_amdgcn_exp2f(-dl); l_reg*=f; if(hi==0)wsf[r32]=f; resc=true; } } \
    SBAR(); \
    GAPB(o[0]=__builtin_amdgcn_mfma_f32_32x32x16_bf16(PAF(0),VFR(0),o[0],0,0,0), C0,0); \
    GAPB(o[1]=__builtin_amdgcn_mfma_f32_32x32x16_bf16(PAF(0),VFR(4),o[1],0,0,0), C0,4); \
    if(GL){ KXLOAD((t)+1); SBAR(); } \
    KRD(GL,0); GAPB(o[0]=__builtin_amdgcn_mfma_f32_32x32x16_bf16(PAF(1),VFR(1),o[0],0,0,0), C0,8); \
    KRD(GL,1); GAPB(o[1]=__builtin_amdgcn_mfma_f32_32x32x16_bf16(PAF(1),VFR(5),o[1],0,0,0), C0,12); \
    KRD(GL,2); GAPB(o[0]=__builtin_amdgcn_mfma_f32_32x32x16_bf16(PAF(2),VFR(2),o[0],0,0,0), C1,0); \
    KRD(GL,3); GAPB(o[1]=__builtin_amdgcn_mfma_f32_32x32x16_bf16(PAF(2),VFR(6),o[1],0,0,0), C1,4); \
    if(GL){ KXMAKE(); SBAR(); } \
    GAPB(o[0]=__builtin_amdgcn_mfma_f32_32x32x16_bf16(PAF(3),VFR(3),o[0],0,0,0), C1,8); \
    GAPB(o[1]=__builtin_amdgcn_mfma_f32_32x32x16_bf16(PAF(3),VFR(7),o[1],0,0,0), C1,12); \
    }while(0)
  int t=1;
  #undef CMASK
  #define CMASK(P0,P1,t) do{}while(0)
  for(;t+5<NT;t+=2){
    STEP(pB0,pB1,pA0,pA1,t,true,true,true);     WAIT_BAR(2); RESC(); ROT();
    STEP(pA0,pA1,pB0,pB1,t+1,true,true,true);   WAIT_BAR(2); RESC(); ROT();
  }
  #undef CMASK
  #define CMASK(P0,P1,t) do{int jb_=(t)-(NT-4); if(jb_>=0)cmask(P0,P1,jb_,qrel,hi);}while(0)
  #define ENDW(tt) do{ if((tt)+3<NT){WAIT_BAR(2);} else if((tt)+2<NT){WAIT_BAR(1);} else {WAIT_BAR(0);} }while(0)
  for(;t+1<NT;t+=2){
    STEP(pB0,pB1,pA0,pA1,t,(t+3<NT),(t+1<NT),(t+1<NT));       ENDW(t);   RESC(); ROT();
    STEP(pA0,pA1,pB0,pB1,t+1,(t+4<NT),(t+2<NT),(t+2<NT));     ENDW(t+1); RESC(); ROT();
  }
  STEP(pB0,pB1,pA0,pA1,NT-1,false,false,false); RESC();
  { float sacc=pB0[0]+pB0[1]; _Pragma("unroll") for(int r=2;r<16;++r)sacc+=pB0[r]; _Pragma("unroll") for(int r=0;r<16;++r)sacc+=pB1[r]; l_reg+=sacc;
    pw0=(u32x4){PKW(pB0,0),PKW(pB0,2),PKW(pB0,4),PKW(pB0,6)};pw1=(u32x4){PKW(pB0,8),PKW(pB0,10),PKW(pB0,12),PKW(pB0,14)};pw2=(u32x4){PKW(pB1,0),PKW(pB1,2),PKW(pB1,4),PKW(pB1,6)};pw3=(u32x4){PKW(pB1,8),PKW(pB1,10),PKW(pB1,12),PKW(pB1,14)};
    SBAR(); pv(o,vb0+sl_cur,PAF(0),PAF(1),PAF(2),PAF(3)); }
  #undef PKW
  #undef PAF
  #undef VFR
  #undef PIN
  #undef MX3
  #undef GAPA
  #undef GAPB
  #undef EX
  #undef VRD
  #undef KRD
  #undef STEP
  #undef ENDW
  {auto rr=__builtin_amdgcn_permlane32_swap(__float_as_uint(l_reg),__float_as_uint(l_reg),false,false);l_reg=__uint_as_float(rr[0])+__uint_as_float(rr[1]);}
  if(hi==0)wsf[32+r32]=l_reg;asm volatile("s_waitcnt lgkmcnt(0)":::"memory");
  float rli[16];
  #pragma unroll
  for(int r=0;r<16;++r)rli[r]=__builtin_amdgcn_rcpf(wsf[32+crow(r,hi)]);
  bf16*Ow=O+(rowbase+q0+wid*QBLK)*DM+h*D;
  { bf16*stg=(bf16*)(shm+LDS_OST)+wid*2048;
    #pragma unroll
    for(int r=0;r<16;++r){const int orow=crow(r,hi);
      #pragma unroll
      for(int d0=0;d0<2;++d0)stg[orow*64+d0*32+r32]=__float2bfloat16(o[d0][r]*rli[r]);}
    asm volatile("s_waitcnt lgkmcnt(0)":::"memory");
    #pragma unroll
    for(int i=0;i<4;++i){const int row=i*8+(lane>>3),ch=lane&7; const u32x4 v=*(const u32x4*)(stg+row*64+ch*8); ATTN_STORE16(Ow+(long)row*DM+ch*8,v);} }
  asm volatile("s_waitcnt lgkmcnt(0)\n\ts_barrier":::"memory");
  #undef DMA_K
  #undef KXLOAD
  #undef QLD
  #undef HM
  #undef KXMAKE
  #undef KXA
  #undef KXB
  #undef QXV
  #undef DMA_V
  #undef CMASK
  #undef START
  #undef RESC
  #undef ROT
}
constexpr int ATTN_LDS_BYTES=LDS_BYTES;
template<int THRL=8> __device__ __forceinline__ void attn_phase(unsigned char*ws,char*lds,int gw_off,int p_off,int tbl_off,int offs_off,const bf16*Q,const bf16*K,const bf16*V,bf16*O,const float*fl,const float*ftot,const float*nmax,unsigned*qhead){
  typedef __attribute__((address_space(3))) float* lds_fw; typedef __attribute__((address_space(3))) int* lds_iw;
  const lds_fw gw=(lds_fw)(lds+gw_off); const lds_fw amax=(lds_fw)(lds+p_off+256); const lds_iw ctl=(lds_iw)(lds+p_off+512); const lds_fw tbl=(lds_fw)(lds+tbl_off); const lds_fw offs=(lds_fw)(lds+offs_off);
  const int tid=threadIdx.x,lane=tid&63; const int wid=__builtin_amdgcn_readfirstlane(tid>>6);
  for(int bh=wid;bh<BATCH*NHEAD;bh+=NW){ const float ft=ftot[((size_t)(bh>>4)*NQB+lane)*NHEAD+(bh&15)]; float inc=ft;
    #pragma unroll
    for(int o_=1;o_<64;o_<<=1){ const float t_=__shfl_up(inc,o_,64); if(lane>=o_)inc+=t_; }
    tbl[bh*NQB+lane]=inc-ft; }
  if(tid==0) ctl[3]=(int)blockIdx.x;
  __syncthreads();
  for(;;){
    int tid=threadIdx.x; asm volatile("":"+v"(tid)); const int lane=tid&63;
    const int qp=ctl[3]; if(qp>=BATCH*NHEAD*NQB+N_CONV_UNITS) break;
    unsigned nextq=0u; if(tid==0) nextq=__hip_atomic_fetch_add(qhead,1u,__ATOMIC_RELAXED,__HIP_MEMORY_SCOPE_AGENT)+gridDim.x;
    if(qp%5==4&&qp/5<N_CONV_UNITS){ ::expert_conv_unit(ws,qp/5,(__attribute__((address_space(3))) unsigned char*)lds); }
    else {
    const int ui=qp-(qp/5<N_CONV_UNITS?qp/5:N_CONV_UNITS);
    const int b=ui&1, rr_=ui>>1, qb=NQB-1-(rr_&(NQB-1)), h=NHEAD-1-(rr_>>6);
    const float*flh=fl+((size_t)b*NHEAD+h)*SEQ; const lds_fw pexu=tbl+(b*NHEAD+h)*NQB;
    float kn=0.f,qn=0.f,g4a=0.f,g4b=0.f,g4c=0.f,g4d=0.f;
    if(wid==0){
      const float4 kq=*(const float4*)(nmax+(((size_t)128+b*NQB+lane)*NHEAD+h)*4), qq=*(const float4*)(nmax+(((size_t)b*NQB+qb)*NHEAD+h)*4);
      if(lane<=qb){ const float*gp=flh+lane*QB+KVBLK-1; g4a=gp[0]; g4b=gp[KVBLK]; g4c=gp[2*KVBLK]; g4d=gp[3*KVBLK]; }
      kn=sqrtf(fmaxf(kq.x,kq.y)+fmaxf(kq.z,kq.w))*1.01f; qn=sqrtf(fmaxf(qq.x,qq.y)+fmaxf(qq.z,qq.w))*1.01f;
    }
    { const int r=tid>>1,hf=tid&1; const size_t ro=((size_t)b*SEQ+qb*QB+r)*DM+h*D+hf*32;
      const u32x4*qv=reinterpret_cast<const u32x4*>(Q+ro); const u32x4*kv=reinterpret_cast<const u32x4*>(K+ro); u32x4 qa[4],ka[4];
      #pragma unroll
      for(int j=0;j<4;++j){ qa[j]=qv[j]; ka[j]=kv[j]; }
      float d=0.f;
      #pragma unroll
      for(int j=0;j<4;++j)
        #pragma unroll
        for(int e=0;e<4;++e){ d+=__uint_as_float(qa[j][e]<<16)*__uint_as_float(ka[j][e]<<16)+__uint_as_float(qa[j][e]&0xffff0000u)*__uint_as_float(ka[j][e]&0xffff0000u); }
      d+=__shfl_xor(d,1,64);
      float a=flh[qb*QB+r]+pexu[qb]-d;
      #pragma unroll
      for(int o_=2;o_<64;o_<<=1) a=fmaxf(a,__shfl_xor(a,o_,64));
      if(lane==0) amax[wid]=a; }
    __syncthreads();
    if(wid==0){
      float A=amax[lane&7];
      #pragma unroll
      for(int o_=1;o_<8;o_<<=1) A=fmaxf(A,__shfl_xor(A,o_,64));
      const float inc=pexu[lane<NQB-1?lane+1:NQB-1];
      const bool skip=(lane<qb)&&(qn*kn+A+0.02f-inc<-70.0f);
      const unsigned long long mk=__ballot(skip); int ns=(~mk)==0ull?64:__builtin_ctzll(~mk); if(ns>qb)ns=qb;
      int nt2=0;
      if(ns<qb){ const float knb=__shfl(kn,ns,64), pb=pexu[ns];
        const float s0_=__shfl(g4a,ns,64),s1_=__shfl(g4b,ns,64),s2_=__shfl(g4c,ns,64),s3_=__shfl(g4d,ns,64); const int c_=lane&3;
        const float gl=(c_==0?s0_:c_==1?s1_:c_==2?s2_:s3_)+pb; const bool sk=(qn*knb+A+0.02f-gl<-70.0f);
        const unsigned long long m2=__ballot(lane<4&&sk)&0xfull; nt2=((m2&3ull)==3ull)?2:0; }
      if(lane==0){ ctl[1]=4*ns+nt2; ctl[2]=__float_as_int(flh[qb*QB]+pexu[qb]); }
    }
    __syncthreads();
    const int t0=ctl[1]; const float ref=__int_as_float(ctl[2]); const int kstart=t0*KVBLK, nk=qb*QB+QB-kstart;
    { const unsigned gdst=(unsigned)(uintptr_t)lds+(unsigned)gw_off; const float*src=flh+kstart; const int nch=(nk+255)>>8;
      for(int c=wid;c<nch;c+=NW) glds16s(src+c*256,(unsigned)lane*16u,(unsigned)__builtin_amdgcn_readfirstlane((int)(gdst+(unsigned)c*1024u))); }
    for(int i=tid;i<(nk>>6);i+=NW*64) offs[i]=pexu[(kstart+i*KVBLK)>>8]-ref;
    attn_unit<THRL>(b,h,qb,t0,Q,K,V,O,lds,(lds_fptr)gw,(lds_fptr)offs);
    }
    if(tid==0) ctl[3]=(int)nextq;
    __syncthreads();
  }
}
#undef SBAR
#undef WAIT_BAR
}

constexpr int NWAVES = 8;
constexpr int N_PHASES = 12;
constexpr size_t WS_SLOTRS = 8 * MiB + 64 * 1024;
constexpr size_t WS_NMAX = 8 * MiB + 512 * 1024;
constexpr size_t WS_WF = 9 * MiB;
constexpr size_t WS_WR = 9 * MiB + 64 * 1024;
constexpr size_t WS_WPOOL = 9 * MiB + 512 * 1024;
constexpr size_t WS_WO = 10 * MiB;
constexpr size_t WS_WQKV = 12 * MiB;
constexpr size_t WS_WD = 18 * MiB;
constexpr size_t WS_WGU = 24 * MiB;
constexpr size_t WS_WEGU = 36 * MiB;
constexpr size_t WS_WED = 92 * MiB;
constexpr size_t WS_X8 = 120 * MiB;
constexpr size_t WS2_XB = 204 * MiB;
constexpr size_t WS2_R = 268 * MiB;
constexpr size_t WS2_END = 500 * MiB;
constexpr int CW_BAR = 4096;
constexpr int CW_QUEUE = 16384;
constexpr size_t CTL_ZERO_BYTES = 128 * 1024;
static_assert((CW_QUEUE + 64) * 4 <= (int)CTL_ZERO_BYTES && (CW_BAR + 3456) * 4 <= (int)CTL_ZERO_BYTES, "control words inside the memset region");
constexpr int RING_BYTES = 131072;
constexpr int ATT_GW_OFF = 83968, ATT_P_OFF = ATT_GW_OFF + 65536 + 1024, MISC_OFF = ATT_P_OFF + 1024, ATT_TBL_OFF = MISC_OFF + 512  , ATT_OFFS_OFF = ATT_TBL_OFF + 8192  , LDS_BYTES = ATT_OFFS_OFF + 1024;
static_assert(LDS_BYTES <= 160 * 1024, "LDS");

#define XB_TMO      128
#define XB_XCNT(j)  (256  + 64 * (j))
#define XB_XSUB(j)  (1280 + 64 * (j))
#define XB_XGEN(j)  (2304 + 64 * (j))
#define XB_TOP      3328
#define XB_TOPGEN   3392
#define XCD_BAR_WORDS 3456
#define XB_SPIN_CAP (1u << 18)
__device__ __forceinline__ unsigned xb_ld(unsigned* p)              { return __hip_atomic_load(p, __ATOMIC_RELAXED, __HIP_MEMORY_SCOPE_AGENT); }
__device__ __forceinline__ unsigned xb_add(unsigned* p, unsigned v) { return __hip_atomic_fetch_add(p, v, __ATOMIC_RELAXED, __HIP_MEMORY_SCOPE_AGENT); }
__device__ __forceinline__ unsigned xb_xcc_id() { return (unsigned)__builtin_amdgcn_s_getreg((3 << 11) | 20) & 0xFu; }
#define XB_SPIN(cond, bar) do { unsigned _sp = 0; while (cond) { __builtin_amdgcn_s_sleep(1); \
    if ((++_sp & 255u) == 0u) { if (xb_ld(&(bar)[XB_TMO])) break; if (_sp > XB_SPIN_CAP) { atomicAdd(&(bar)[XB_TMO], 1u); break; } } } } while (0)
struct XcdBarrier { unsigned* bar; unsigned x; volatile LAS unsigned* st; };
__device__ __forceinline__ XcdBarrier xcd_barrier_post(unsigned* bar, volatile LAS unsigned* st, bool t0) {
    XcdBarrier b; b.bar = bar; b.x = xb_xcc_id(); b.st = st;
    if (t0) (void)xb_add(&bar[XB_XCNT(b.x)], 1u);
    return b;
}
__device__ __forceinline__ void xcd_barrier_complete(unsigned* bar, unsigned x, unsigned& nloc, unsigned& nx) {
    const unsigned G = gridDim.x * gridDim.y * gridDim.z;
    unsigned sum, cnt, mine, sp = 0u;
    for (;;) {
        sum = 0u; cnt = 0u; mine = 0u;
#pragma unroll
        for (unsigned j = 0; j < 16; ++j) { const unsigned c = xb_ld(&bar[XB_XCNT(j)]); sum += c; cnt += (c > 0u) ? 1u : 0u; mine = (j == x) ? c : mine; }
        if (sum == G) break;
        __builtin_amdgcn_s_sleep(1);
        if ((++sp & 255u) == 0u) { if (xb_ld(&bar[XB_TMO])) break; if (sp > XB_SPIN_CAP) { atomicAdd(&bar[XB_TMO], 1u); break; } }
    }
    nloc = mine > 0u ? mine : 1u; nx = cnt > 0u ? cnt : 1u;
}
__device__ __forceinline__ void xcd_barrier(const XcdBarrier& b, bool t0) {
    asm volatile("s_waitcnt vmcnt(0)" ::: "memory");
    __syncthreads();
    if (t0) {
        unsigned* bar = b.bar;
        __builtin_amdgcn_s_waitcnt(0);
        unsigned nloc = b.st[0], nx = b.st[1];
        if (nloc == 0u) { xcd_barrier_complete(bar, b.x, nloc, nx); b.st[0] = nloc; b.st[1] = nx; }
        const unsigned old = xb_add(&bar[XB_XSUB(b.x)], 1u);
        const unsigned gen = old / nloc;
        if (old + 1u == (gen + 1u) * nloc) {
            __builtin_amdgcn_fence(__ATOMIC_RELEASE, "agent");
            asm volatile("s_waitcnt vmcnt(0)" ::: "memory");
            const unsigned og = xb_add(&bar[XB_TOP], 1u);
            const unsigned tg = og / nx;
            if (og + 1u == (tg + 1u) * nx) xb_add(&bar[XB_TOPGEN], 1u);
            else XB_SPIN(xb_ld(&bar[XB_TOPGEN]) == tg, bar);
            __builtin_amdgcn_fence(__ATOMIC_ACQUIRE, "agent");
            xb_add(&bar[XB_XGEN(b.x)], 1u);
            asm volatile("s_waitcnt vmcnt(0)" ::: "memory");
        } else {
            XB_SPIN(xb_ld(&bar[XB_XGEN(b.x)]) == gen, bar);
            __builtin_amdgcn_fence(__ATOMIC_ACQUIRE, "agent");
            asm volatile("s_waitcnt vmcnt(0)" ::: "memory");
        }
    }
    __syncthreads();
}

#define KARG(i) (*(const float* const volatile __attribute__((address_space(4)))*)((const __attribute__((address_space(4))) char*)__builtin_amdgcn_kernarg_segment_ptr() + 8 * (i)))
struct Args { const float* in[18]; float* out; unsigned char* ws; int ph_lo, ph_hi, use_bar, pad; };
struct Ctx {
    LAS unsigned char* lds; int tid, lane, wave, vcu, G;
    float* out; unsigned char* ws;
};

template <bool FP8>
__device__ __forceinline__ void conv_item64(const float* W, int pitch, int k0, int n0, const float* gk, const float* gn, float cst, void* dst  , int dK, LAS float* scr, int lane) {
    const int nq = 4 * (lane & 15), kr = lane >> 4;
    f32x4 v[16];
#pragma unroll
    for (int i = 0; i < 16; ++i) v[i] = *(const f32x4*)(W + (size_t)(k0 + 4 * i + kr) * pitch + n0 + nq);
    f32x4 sn = (f32x4){cst, cst, cst, cst}; if (gn) sn = sn * *(const f32x4*)(gn + n0 + nq);
#pragma unroll
    for (int i = 0; i < 16; ++i) { const int kk = 4 * i + kr; const f32x4 w = v[i] * sn * (gk ? gk[k0 + kk] : 1.0f); LAS float* s = scr + kk * 65 + nq; s[0] = w[0]; s[1] = w[1]; s[2] = w[2]; s[3] = w[3]; }
    LDS_WAIT(); asm volatile("" ::: "memory");
    const int c = lane & 7;
#pragma unroll
    for (int j = 0; j < 8; ++j) { const int n = (lane >> 3) + 8 * j; const LAS float* s = scr + (8 * c) * 65 + n;
        if constexpr (FP8) { uint2 o; o.x = pg8::pk4_fp8(s[0 * 65], s[1 * 65], s[2 * 65], s[3 * 65]); o.y = pg8::pk4_fp8(s[4 * 65], s[5 * 65], s[6 * 65], s[7 * 65]);
            *(uint2*)((unsigned char*)dst + (size_t)n * dK + k0 + 8 * c) = o; }
        else { v4u o; o.x = pk2(s[0 * 65], s[1 * 65]); o.y = pk2(s[2 * 65], s[3 * 65]); o.z = pk2(s[4 * 65], s[5 * 65]); o.w = pk2(s[6 * 65], s[7 * 65]);
            *(GAS v4u*)((bf16*)dst + (size_t)n * dK + k0 + 8 * c) = o; } }
    LDS_WAIT(); asm volatile("" ::: "memory");
}
template <bool FP8>
__device__ __forceinline__ void conv_matrix_item(const float* W, int pitch, int K, int N, const float* gk, const float* gn, float cst, void* dst, int mode, int item, LAS float* scr, int lane) {
    const int nblk = N / 64, kb = item / nblk, nb = item - kb * nblk, n0 = 64 * nb;
    const int drow = mode == 0 ? n0 : (n0 >> 7) * 256 + (n0 & 127) + (mode == 2 ? 128 : 0);
    conv_item64<FP8>(W, pitch, 64 * kb, n0, gk, gn, cst, (unsigned char*)dst + (size_t)drow * K * (FP8 ? 1 : 2), K, scr, lane);
}
struct ConvD { const float* W; int pitch, k0, n0; const float* gk; unsigned char* dst; int dK; };
__device__ __forceinline__ ConvD expert_item(unsigned char* ws, int r) {
    constexpr int I_EGU = 16 * (FFE / 64), I_ED = (FFE / 64) * 16;
    const int e = r / (2 * I_EGU + I_ED); r -= e * (2 * I_EGU + I_ED);
    ConvD d; int mode, K, N;
    if (r < 2 * I_EGU) { const bool up = r >= I_EGU; if (up) r -= I_EGU; d.W = (up ? KARG(15) : KARG(14)) + (size_t)e * D * FFE; d.pitch = FFE; K = D; N = FFE; d.gk = KARG(2) + D; d.dst = ws + WS_WEGU + (size_t)e * 2 * FFE * D; mode = up ? 2 : 1; }
    else { r -= 2 * I_EGU; d.W = KARG(16) + (size_t)e * FFE * D; d.pitch = D; K = FFE; N = D; d.gk = nullptr; d.dst = ws + WS_WED + (size_t)e * D * FFE; mode = 0; }
    const int nblk = N / 64, kb = r / nblk, nb = r - kb * nblk, n0 = 64 * nb;
    const int drow = mode == 0 ? n0 : (n0 >> 7) * 256 + (n0 & 127) + (mode == 2 ? 128 : 0);
    d.k0 = 64 * kb; d.n0 = n0; d.dst += (size_t)drow * K; d.dK = K; return d;
}
__device__ __forceinline__ void conv_load(const ConvD& d, f32x4 (&v)[16], float& g, int lane) {
    const int nq = 4 * (lane & 15), kr = lane >> 4;
#pragma unroll
    for (int i = 0; i < 16; ++i) v[i] = __builtin_nontemporal_load((const f32x4*)(d.W + (size_t)(d.k0 + 4 * i + kr) * d.pitch + d.n0 + nq));
    g = 1.0f; if (d.gk) g = d.gk[d.k0 + lane];
}
__device__ __forceinline__ void conv_finish8(const ConvD& d, const f32x4 (&v)[16], float g, LAS float* scr, int lane) {
    const int nq = 4 * (lane & 15), kr = lane >> 4;
#pragma unroll
    for (int i = 0; i < 16; ++i) { const int kk = 4 * i + kr; const f32x4 w = v[i] * (__shfl(g, kk, 64) * 256.0f); LAS float* s = scr + kk * 65 + nq; s[0] = w[0]; s[1] = w[1]; s[2] = w[2]; s[3] = w[3]; }
    LDS_WAIT(); asm volatile("" ::: "memory");
    const int c = lane & 7;
#pragma unroll
    for (int j = 0; j < 8; ++j) { const int n = (lane >> 3) + 8 * j; const LAS float* s = scr + (8 * c) * 65 + n;
        uint2 o; o.x = pg8::pk4_fp8(s[0 * 65], s[1 * 65], s[2 * 65], s[3 * 65]); o.y = pg8::pk4_fp8(s[4 * 65], s[5 * 65], s[6 * 65], s[7 * 65]);
        typedef unsigned u32x2_t __attribute__((ext_vector_type(2))); __builtin_nontemporal_store((u32x2_t){o.x, o.y}, (u32x2_t*)(d.dst + (size_t)n * d.dK + d.k0 + 8 * c)); }
    LDS_WAIT(); asm volatile("" ::: "memory");
}
__device__ __forceinline__ void expert_conv_unit(unsigned char* ws, int cu, LAS unsigned char* lds) {
    int tid = threadIdx.x; asm volatile("" : "+v"(tid)); const int lane = tid & 63, wave = __builtin_amdgcn_readfirstlane(tid >> 6);
    LAS float* scr = (LAS float*)(lds + wave * 16640);
    const int base = cu * CONV_ITEMS_PER_UNIT + wave; constexpr int NQ = CONV_ITEMS_PER_UNIT / NWAVES;
    f32x4 vA[16], vB[16]; float gA, gB;
    ConvD dA = expert_item(ws, base), dB; conv_load(dA, vA, gA, lane);
#pragma unroll
    for (int q = 0; q < NQ; q += 2) {
        dB = expert_item(ws, base + (q + 1) * NWAVES); conv_load(dB, vB, gB, lane); __builtin_amdgcn_sched_barrier(0);
        conv_finish8(dA, vA, gA, scr, lane); __builtin_amdgcn_sched_barrier(0);
        if (q + 2 < NQ) { dA = expert_item(ws, base + (q + 2) * NWAVES); conv_load(dA, vA, gA, lane); __builtin_amdgcn_sched_barrier(0); }
        conv_finish8(dB, vB, gB, scr, lane); __builtin_amdgcn_sched_barrier(0);
    }
}
__device__ __forceinline__ void p0_prologue(Ctx& F) {
    unsigned char* ws = F.ws;
    {
        LAS float* xr = (LAS float*)F.lds;
        LAS float* rr = (LAS float*)(F.lds + 131072);
        bf16* pooled = (bf16*)(ws + WS2_R);
        const int lr = F.tid >> 8, lc = 4 * (F.tid & 255);
        const int c = 2 * F.tid, w = 2 << (F.tid >> 7);
        const float g0 = KARG(1)[c], g1 = KARG(1)[c + 1];
        for (int chunk = F.vcu; chunk < M / 128; chunk += F.G) {
            const int t0 = chunk * 128, first = (t0 % SEQ == 0) ? t0 : t0 - 15, nrows = t0 + 128 - first;
            const float* xg = KARG(0) + (size_t)first * D + lc;
            f32x4 nx[8];
#pragma unroll
            for (int j = 0; j < 8; ++j) { const int r = lr + 2 * j; nx[j] = r < nrows ? *(const f32x4*)(xg + (size_t)r * D) : (f32x4){0.f, 0.f, 0.f, 0.f}; }
            float s0 = 0.f, s1 = 0.f;
            for (int rb = 0; rb < nrows; rb += 16) {
#pragma unroll
                for (int j = 0; j < 8; ++j) *(LAS f32x4*)(xr + ((rb + lr + 2 * j) & 31) * 1024 + lc) = nx[j];
                if (rb + 16 < nrows) {
#pragma unroll
                    for (int j = 0; j < 8; ++j) { const int r = rb + 16 + lr + 2 * j; nx[j] = r < nrows ? *(const f32x4*)(xg + (size_t)r * D) : (f32x4){0.f, 0.f, 0.f, 0.f}; }
                }
                __syncthreads();
#pragma unroll
                for (int q = 0; q < 2; ++q) { const int r = rb + 2 * F.wave + q; LAS const f32x4* p = (LAS const f32x4*)(xr + (r & 31) * 1024) + F.lane; float s = 0.f;
#pragma unroll
                    for (int j = 0; j < 4; ++j) { const f32x4 v = p[64 * j]; s += (v[0] * v[0] + v[1] * v[1]) + (v[2] * v[2] + v[3] * v[3]); }
                    s = wave_sum(s); if (F.lane == 0) rr[r & 31] = 1.0f / sqrtf(s * (1.0f / D) + EPS); }
                __syncthreads();
                const int nb = nrows - rb < 16 ? nrows - rb : 16;
#pragma unroll 4
                for (int i = 0; i < nb; ++i) { const int r = rb + i;
                    const f32x2 xv = *(LAS const f32x2*)(xr + (r & 31) * 1024 + c); const float ri = rr[r & 31];
                    const float h0 = xv[0] * ri * g0, h1 = xv[1] * ri * g1; s0 += h0; s1 += h1;
                    if (r >= w) { const f32x2 xo = *(LAS const f32x2*)(xr + ((r - w) & 31) * 1024 + c); const float ro = rr[(r - w) & 31]; s0 -= xo[0] * ro * g0; s1 -= xo[1] * ro * g1; }
                    if (first + r >= t0) { const int ts = (first + r) % SEQ; const float ic = 1.0f / (float)(ts + 1 < w ? ts + 1 : w);
                        *(unsigned*)(pooled + (size_t)(first + r) * D + c) = pk2(s0 * ic - h0, s1 * ic - h1); }
                }
                __syncthreads();
            }
        }
    }
    {
        LAS float* scr = (LAS float*)(F.lds + F.wave * 16640);
        const int gw = F.vcu * NWAVES + F.wave, NGW = F.G * NWAVES;
        constexpr int I_POOL = 4 * 4, I_DGU = 16 * (FFD / 64), I_DD = (FFD / 64) * 16, I_SQ = 16 * 16;
        constexpr int NITEMS = 4 * I_POOL + 2 * I_DGU + I_DD + 4 * I_SQ;
        bf16* wpool = (bf16*)(ws + WS_WPOOL); bf16* wo = (bf16*)(ws + WS_WO); bf16* wqkv = (bf16*)(ws + WS_WQKV); bf16* wd = (bf16*)(ws + WS_WD); bf16* wgu = (bf16*)(ws + WS_WGU);
        for (int it = gw; it < NITEMS; it += NGW) {
            int r = it;
            if (r < 4 * I_POOL) { const int g = r / I_POOL; conv_matrix_item<false>(KARG(3) + (size_t)g * 65536, 256, 256, 256, nullptr, KARG(4) + g * 256, 1.0f, wpool + (size_t)g * 65536, 0, r % I_POOL, scr, F.lane); continue; } r -= 4 * I_POOL;
            if (r < I_DGU) { conv_matrix_item<false>(KARG(10), FFD, D, FFD, KARG(2), nullptr, 1.0f, wgu, 1, r, scr, F.lane); continue; } r -= I_DGU;
            if (r < I_DGU) { conv_matrix_item<false>(KARG(11), FFD, D, FFD, KARG(2), nullptr, 1.0f, wgu, 2, r, scr, F.lane); continue; } r -= I_DGU;
            if (r < I_DD) { conv_matrix_item<false>(KARG(12), D, FFD, D, nullptr, nullptr, 1.0f, wd, 0, r, scr, F.lane); continue; } r -= I_DD;
            if (r < I_SQ) { conv_matrix_item<false>(KARG(8), D, D, D, KARG(1) + D, nullptr, C2, wqkv, 0, r, scr, F.lane); continue; } r -= I_SQ;
            if (r < I_SQ) { conv_matrix_item<false>(KARG(6), KVW, D, D, KARG(5), nullptr, 1.0f, wqkv + (size_t)D * D, 0, r, scr, F.lane); continue; } r -= I_SQ;
            if (r < I_SQ) { conv_matrix_item<false>(KARG(6) + D, KVW, D, D, KARG(5), nullptr, 1.0f, wqkv + (size_t)2 * D * D, 0, r, scr, F.lane); continue; } r -= I_SQ;
            conv_matrix_item<false>(KARG(9), D, D, D, nullptr, nullptr, 1.0f, wo, 0, r, scr, F.lane);
        }
        bf16* wfh = (bf16*)(ws + WS_WF); bf16* wrh = (bf16*)(ws + WS_WR);
        for (int i = F.vcu * 512 + F.tid; i < 2 * NH * D; i += F.G * 512) {
            const int which = i >> 14, j = i & 16383, row = j >> 10, kk = j & 1023; float w;
            if (which == 0) w = KARG(6)[(size_t)kk * KVW + 2 * D + row] * KARG(5)[kk]; else w = row < NE ? KARG(13)[kk * NE + row] * KARG(2)[D + kk] : 0.0f;
            const bf16 h = f2bf(w), l = f2bf(w - bf2f(h)); bf16* t = which == 0 ? wfh : wrh; t[j] = h; t[NH * D + j] = l;
        }
    }
}


__device__ __forceinline__ void fgate_tile(Ctx& F, int tile) {
    unsigned char* ws = F.ws; const bf16* xb = (const bf16*)(ws + WS2_XB); const float* wf = (const float*)(ws + WS_WF); const float* stats = (const float*)(ws + WS_STATS);
    float* fl = (float*)(ws + WS_FL); float* ftot = (float*)(ws + WS_FTOT);
    LAS float* zt = (LAS float*)F.lds;
    const int fr = F.lane & 15, fq = F.lane >> 4, row0 = tile * 256 + F.wave * 32;
    f32x4 acc[2] = {(f32x4){0.f, 0.f, 0.f, 0.f}, (f32x4){0.f, 0.f, 0.f, 0.f}};
    const bf16* xa = xb + (size_t)(row0 + fr) * D + 8 * fq; const bf16* wb = (const bf16*)wf + (size_t)fr * D + 8 * fq;
#pragma unroll 8
    for (int s = 0; s < 32; ++s) {
        const bf16x8 bh = *(const bf16x8*)(wb + 32 * s), bl = *(const bf16x8*)(wb + NH * D + 32 * s);
#pragma unroll
        for (int rg = 0; rg < 2; ++rg) { const bf16x8 a = *(const bf16x8*)(xa + (size_t)rg * 16 * D + 32 * s);
            acc[rg] = __builtin_amdgcn_mfma_f32_16x16x32_bf16(a, bh, acc[rg], 0, 0, 0); acc[rg] = __builtin_amdgcn_mfma_f32_16x16x32_bf16(a, bl, acc[rg], 0, 0, 0); }
    }
    const float bfh = KARG(7)[fr];
#pragma unroll
    for (int rg = 0; rg < 2; ++rg)
#pragma unroll
        for (int i = 0; i < 4; ++i) { const int rl = F.wave * 32 + rg * 16 + 4 * fq + i; const float z = acc[rg][i] * pg8::rinv_from_stats(stats, tile * 256 + rl) + bfh;
            zt[rl * 17 + fr] = (fminf(z, 0.f) - log1pf(__expf(-fabsf(z)))) * LOG2E; }
    __syncthreads();
    { const int h = 2 * F.wave + (F.lane >> 5), seg = F.lane & 31; float v[8]; float s = 0.f;
#pragma unroll
      for (int i = 0; i < 8; ++i) { s += zt[(seg * 8 + i) * 17 + h]; v[i] = s; }
      float inc = s;
#pragma unroll
      for (int o = 1; o < 32; o <<= 1) { const float t = __shfl_up(inc, o, 32); if (seg >= o) inc += t; }
      const float pre = inc - s; const int b = tile / NTILE, tl = tile % NTILE;
      float* fo = fl + ((size_t)b * NH + h) * SEQ + tl * 256 + seg * 8;
      *(f32x4*)fo = (f32x4){v[0] + pre, v[1] + pre, v[2] + pre, v[3] + pre}; *(f32x4*)(fo + 4) = (f32x4){v[4] + pre, v[5] + pre, v[6] + pre, v[7] + pre};
      if (seg == 31) ftot[((size_t)b * NTILE + tl) * NH + h] = inc; }
    __syncthreads();
}


__device__ __forceinline__ void router_tile(Ctx& F, int hc) {
    unsigned char* ws = F.ws; const bf16* xb = (const bf16*)(ws + WS2_XB); const float* wrt = (const float*)(ws + WS_WR); const float* stats = (const float*)(ws + WS_STATS);
    int* toke = (int*)(ws + WS_TOKE); float* tokw = (float*)(ws + WS_TOKW); float* rinv3 = (float*)(ws + WS_RINV3); int* chist = (int*)(ws + WS_CHIST);
    LAS float* lg = (LAS float*)F.lds;
    LAS int* cnt = (LAS int*)(F.lds + 128 * 9 * 4);
    const int fr = F.lane & 15, fq = F.lane >> 4, row0 = hc * 128 + F.wave * 16;
    if (F.tid < NE) cnt[F.tid] = 0;
    f32x4 acc = (f32x4){0.f, 0.f, 0.f, 0.f};
    const bf16* xa = xb + (size_t)(row0 + fr) * D + 8 * fq; const bf16* wb = (const bf16*)wrt + (size_t)fr * D + 8 * fq;
    const float ri8 = pg8::rinv_from_stats(stats, row0 + fr) * 8.0f; unsigned char* x8r = ws + WS_X8 + (size_t)(row0 + fr) * D + 8 * fq;
#pragma unroll 8
    for (int s = 0; s < 32; ++s) {
        const bf16x8 bh = *(const bf16x8*)(wb + 32 * s), bl = *(const bf16x8*)(wb + NH * D + 32 * s), a = *(const bf16x8*)(xa + 32 * s);
        acc = __builtin_amdgcn_mfma_f32_16x16x32_bf16(a, bh, acc, 0, 0, 0); acc = __builtin_amdgcn_mfma_f32_16x16x32_bf16(a, bl, acc, 0, 0, 0);
        const v4u aw = __builtin_bit_cast(v4u, a); uint2 p8;
        p8.x = pg8::pk4_fp8(__uint_as_float(aw[0] << 16) * ri8, __uint_as_float(aw[0] & 0xffff0000u) * ri8, __uint_as_float(aw[1] << 16) * ri8, __uint_as_float(aw[1] & 0xffff0000u) * ri8);
        p8.y = pg8::pk4_fp8(__uint_as_float(aw[2] << 16) * ri8, __uint_as_float(aw[2] & 0xffff0000u) * ri8, __uint_as_float(aw[3] << 16) * ri8, __uint_as_float(aw[3] & 0xffff0000u) * ri8);
        *(uint2*)(x8r + 32 * s) = p8;
    }
    if (fr < NE) {
#pragma unroll
        for (int i = 0; i < 4; ++i) lg[(F.wave * 16 + 4 * fq + i) * 9 + fr] = acc[i];
    }
    __syncthreads();
    if (F.tid < 128) { const int t = hc * 128 + F.tid; float v[NE];
#pragma unroll
        for (int e = 0; e < NE; ++e) v[e] = lg[F.tid * 9 + e];
        int e0 = 0; float v0 = v[0];
#pragma unroll
        for (int e = 1; e < NE; ++e) if (v[e] > v0) { v0 = v[e]; e0 = e; }
        int e1 = -1; float v1 = -3e38f;
#pragma unroll
        for (int e = 0; e < NE; ++e) if (e != e0 && v[e] > v1) { v1 = v[e]; e1 = e; }
        const float ri = pg8::rinv_from_stats(stats, t), w0 = 1.0f / (1.0f + __expf((v1 - v0) * ri));
        rinv3[t] = ri; *(int2*)(toke + 2 * t) = make_int2(e0, e1); *(float2*)(tokw + 2 * t) = make_float2(w0, 1.0f - w0);
        __hip_atomic_fetch_add(cnt + e0, 1, __ATOMIC_RELAXED, __HIP_MEMORY_SCOPE_WORKGROUP); __hip_atomic_fetch_add(cnt + e1, 1, __ATOMIC_RELAXED, __HIP_MEMORY_SCOPE_WORKGROUP); }
    __syncthreads();
    if (F.tid < NE) chist[hc * NE + F.tid] = cnt[F.tid];
    __syncthreads();
}
__device__ __forceinline__ void lists_phase(Ctx& F) {
    unsigned char* ws = F.ws; const int* chist = (const int*)(ws + WS_CHIST); const int* toke = (const int*)(ws + WS_TOKE); const float* tokw = (const float*)(ws + WS_TOKW);
    const float* rinv3 = (const float*)(ws + WS_RINV3); int* tilee = (int*)(ws + WS_TILEE); int* slottok = (int*)(ws + WS_SLOTTOK); int2* slotinfo = (int2*)(ws + WS_SLOTINFO); float* slotrs = (float*)(ws + WS_SLOTRS);
    LAS int* coffL = (LAS int*)F.lds;
    LAS int* tot = coffL + 128 * NE; LAS int* pbase = tot + NE;
    LAS unsigned long long* bal = (LAS unsigned long long*)(F.lds + 8192);
    { const int e = F.wave, j = F.lane; const int a = chist[(4 * j) * NE + e] + chist[(4 * j + 1) * NE + e], b = chist[(4 * j + 2) * NE + e] + chist[(4 * j + 3) * NE + e], s = a + b; int inc = s;
#pragma unroll
      for (int o = 1; o < 64; o <<= 1) { const int t = __shfl_up(inc, o, 64); if (j >= o) inc += t; }
      coffL[(2 * j) * NE + e] = inc - s; coffL[(2 * j + 1) * NE + e] = inc - s + a; if (j == 63) tot[e] = inc; }
    __syncthreads();
    if (F.tid == 0) { int p = 0; for (int e = 0; e < NE; ++e) { pbase[e] = p; p += (tot[e] + 255) / 256 * 256; } pbase[NE] = p; }
    __syncthreads();
    if (blockIdx.x == 0) {
        for (int tl = F.tid; tl < MAXT; tl += NWAVES * 64) { int e = 0; while (e < NE - 1 && tl * 256 >= pbase[e + 1]) ++e; tilee[tl] = e; }
        if (F.tid == 0) tilee[300] = pbase[NE] / 256;
        for (int e = 0; e < NE; ++e) for (int s = pbase[e] + tot[e] + F.tid; s < pbase[e + 1]; s += NWAVES * 64) { slottok[s] = 0; slotinfo[s] = make_int2(-1, 0); slotrs[s] = 0.f; }
    }
    for (int ch = F.vcu; ch < M / 256; ch += F.G) {
        const int i = F.tid, e = toke[ch * 512 + i];
#pragma unroll
        for (int x = 0; x < NE; ++x) { const unsigned long long bm = __ballot(e == x); if (F.lane == 0) bal[F.wave * NE + x] = bm; }
        __syncthreads();
        int pos = __popcll(bal[F.wave * NE + e] & ((1ull << F.lane) - 1ull));
        for (int w2 = 0; w2 < F.wave; ++w2) pos += __popcll(bal[w2 * NE + e]);
        const int slot = pbase[e] + coffL[ch * NE + e] + pos, yrow = ch * 512 + i;
        slottok[slot] = yrow >> 1; slotinfo[slot] = make_int2(yrow, __float_as_int(tokw[yrow])); slotrs[slot] = rinv3[yrow >> 1];
        __syncthreads();
    }
}
__device__ __forceinline__ void final_phase(Ctx& F) {
    const bf16* xb = (const bf16*)(F.ws + WS2_XB);
    f32x4 g[2][2];
#pragma unroll
    for (int j = 0; j < 2; ++j) { const int c = (F.lane + 64 * j) * 8; g[j][0] = *(const f32x4*)(KARG(17) + c); g[j][1] = *(const f32x4*)(KARG(17) + c + 4); }
    const int step = F.G * NWAVES;
    for (int t0 = F.vcu * NWAVES + F.wave; t0 < M; t0 += 2 * step) {
        v4u a[2][2], y0[2][2], y1[2][2];
#pragma unroll
        for (int k2 = 0; k2 < 2; ++k2) { const int t = t0 + k2 * step; if (t < M) { const v4u* yr = (const v4u*)((const bf16*)F.out + (size_t)t * 2 * D); const v4u* xr = (const v4u*)(xb + (size_t)t * D);
#pragma unroll
            for (int j = 0; j < 2; ++j) { a[k2][j] = xr[F.lane + 64 * j]; y0[k2][j] = yr[F.lane + 64 * j]; y1[k2][j] = yr[128 + F.lane + 64 * j]; } } }
#pragma unroll
        for (int k2 = 0; k2 < 2; ++k2) { const int t = t0 + k2 * step; if (t < M) { float v[16]; float s = 0.f;
#pragma unroll
            for (int j = 0; j < 2; ++j)
#pragma unroll
                for (int q = 0; q < 4; ++q) { const float lo = __uint_as_float(a[k2][j][q] << 16) + __uint_as_float(y0[k2][j][q] << 16) + __uint_as_float(y1[k2][j][q] << 16);
                    const float hi = __uint_as_float(a[k2][j][q] & 0xffff0000u) + __uint_as_float(y0[k2][j][q] & 0xffff0000u) + __uint_as_float(y1[k2][j][q] & 0xffff0000u);
                    v[j * 8 + 2 * q] = lo; v[j * 8 + 2 * q + 1] = hi; s += lo * lo + hi * hi; }
            s = wave_sum(s); const float ri = 1.0f / sqrtf(s * (1.0f / D) + EPS);
#pragma unroll
            for (int j = 0; j < 2; ++j) { float* o = F.out + (size_t)t * D + (F.lane + 64 * j) * 8;
                *(f32x4*)o = (f32x4){v[j * 8] * ri * g[j][0][0], v[j * 8 + 1] * ri * g[j][0][1], v[j * 8 + 2] * ri * g[j][0][2], v[j * 8 + 3] * ri * g[j][0][3]};
                *(f32x4*)(o + 4) = (f32x4){v[j * 8 + 4] * ri * g[j][1][0], v[j * 8 + 5] * ri * g[j][1][1], v[j * 8 + 6] * ri * g[j][1][2], v[j * 8 + 7] * ri * g[j][1][3]}; } } }
    }
}

__global__ void __launch_bounds__(NWAVES * 64, 2) mk_fwd(Args args) {
    extern __shared__ __attribute__((aligned(16))) unsigned char lds[];
    Ctx F;
    F.lds = (LAS unsigned char*)lds; F.tid = threadIdx.x; F.lane = F.tid & 63; F.wave = __builtin_amdgcn_readfirstlane(F.tid >> 6);
    F.G = gridDim.x; { const int bx = blockIdx.x; F.vcu = (F.G % 8 == 0) ? (bx % 8) * (F.G / 8) + bx / 8 : bx; }
    F.out = args.out; F.ws = args.ws;
    unsigned char* ws = args.ws;
    unsigned* ctl = (unsigned*)(ws + WS_CTL);
    volatile LAS unsigned* MISC = (volatile LAS unsigned*)(F.lds + MISC_OFF);
    for (int u = F.tid; u < 128; u += NWAVES * 64) MISC[u] = 0u;
    __syncthreads();
    XcdBarrier bar; bar.bar = ctl + CW_BAR; bar.x = 0; bar.st = nullptr;
    if (args.use_bar) bar = xcd_barrier_post(ctl + CW_BAR, MISC + 8, F.wave == 0 && lane_id() == 0);
    const int lo = args.ph_lo, hi = args.ph_hi;
#define IN(k) (lo <= (k) && (k) < hi)
#define REFRESH() do { int l_ = lane_id(); asm volatile("" : "+v"(l_)); F.lane = l_; F.tid = F.wave * 64 + l_; } while (0)
#define SEAM(k) do { if (IN(k) && IN((k) + 1)) xcd_barrier(bar, F.wave == 0 && lane_id() == 0); } while (0)
    bf16* xb = (bf16*)(ws + WS2_XB); float* stats = (float*)(ws + WS_STATS);

    if (IN(0)) { REFRESH(); p0_prologue(F); } SEAM(0);
    if (IN(1)) {
        pg8::Gemm g{(const bf16*)(ws + WS2_R), (const bf16*)(ws + WS_WPOOL), D, 256, 256};
        pg8::RegOrder S; S.init(M, D, F.G, (int)blockIdx.x, D, 256, 512u);
        pg8::EpiRes E{KARG(0), xb, stats, nullptr};
        pg8::gemm_phase<pg8::EpiRes, pg8::RegOrder, true>(F.lds, g, S, E);
    } SEAM(1);
    if (IN(2)) {
        pg8::Gemm g{xb, (const bf16*)(ws + WS_WGU), D, D, D};
        pg8::RegOrder S; S.init(M, 2 * FFD, F.G, (int)blockIdx.x, D, D, 0u);
        pg8::EpiGU E{(bf16*)(ws + WS2_R), FFD, stats};
        pg8::gemm_phase<pg8::EpiGU, pg8::RegOrder, true>(F.lds, g, S, E);
    } SEAM(2);
    if (IN(3)) {
        pg8::Gemm g{(const bf16*)(ws + WS2_R), (const bf16*)(ws + WS_WD), FFD, FFD, FFD};
        pg8::RegOrder S; S.init(M, D, F.G, (int)blockIdx.x, FFD, FFD, 0u);
        pg8::EpiRes E{nullptr, xb, stats, nullptr};
        pg8::gemm_phase<pg8::EpiRes, pg8::RegOrder, true>(F.lds, g, S, E);
    } SEAM(3);
    if (IN(4)) {
        REFRESH(); for (int tile = F.vcu; tile < M / 256; tile += F.G) fgate_tile(F, tile);
        { const int idle = F.G > M / 256 ? F.G - M / 256 : 0;
          if (F.vcu >= M / 256 && F.vcu - M / 256 < CONV_P4) { expert_conv_unit(ws, N_CONV_UNITS + F.vcu - M / 256, F.lds); __syncthreads(); }
          for (int u = idle + F.vcu; u < CONV_P4; u += F.G) { expert_conv_unit(ws, N_CONV_UNITS + u, F.lds); __syncthreads(); } }
        pg8::Gemm g{xb, (const bf16*)(ws + WS_WQKV), D, D, D};
        pg8::RegOrder S; S.init(M, 3 * D, F.G, (int)blockIdx.x, D, D, 0u);
        pg8::EpiQKV E{(bf16*)(ws + WS2_R), (size_t)32 * MiB, stats, (float*)(ws + WS_NMAX)};
        pg8::gemm_phase<pg8::EpiQKV, pg8::RegOrder, true>(F.lds, g, S, E);
    } SEAM(4);
    if (IN(5)) {
        attn_body::attn_phase<8>(ws, (char*)lds, ATT_GW_OFF, ATT_P_OFF, ATT_TBL_OFF, ATT_OFFS_OFF, (const attn_body::bf16*)(ws + WS2_R), (const attn_body::bf16*)(ws + WS2_R + 64 * MiB), (const attn_body::bf16*)(ws + WS2_R + 128 * MiB),
                                 (attn_body::bf16*)(ws + WS2_R), (const float*)(ws + WS_FL), (const float*)(ws + WS_FTOT), (const float*)(ws + WS_NMAX), ctl + CW_QUEUE);
    } SEAM(5);
    if (IN(6)) {
        pg8::Gemm g{(const bf16*)(ws + WS2_R), (const bf16*)(ws + WS_WO), D, D, D};
        pg8::RegOrder S; S.init(M, D, F.G, (int)blockIdx.x, D, D, 0u);
        pg8::EpiRes E{nullptr, xb, stats, nullptr};
        pg8::gemm_phase<pg8::EpiRes, pg8::RegOrder, true>(F.lds, g, S, E);
    } SEAM(6);
    if (IN(7)) { REFRESH(); for (int hc = F.vcu; hc < M / 128; hc += F.G) router_tile(F, hc); } SEAM(7);
    if (IN(8)) { REFRESH(); lists_phase(F); } SEAM(8);
    if (IN(9)) {
        const int ntl = ((const int*)(ws + WS_TILEE))[300]; LAS int* tl = (LAS int*)(F.lds + pg8::STAGE_BYTES + 8192);
        { int t_ = F.wave * 64 + lane_id(); asm volatile("" : "+v"(t_)); for (int i = t_; i < ntl; i += NWAVES * 64) tl[i] = ((const int*)(ws + WS_TILEE))[i]; }
        __syncthreads();
        pg8::Gemm g{(const bf16*)(ws + WS_X8), (const bf16*)(ws + WS_WEGU), D, D, D};
        pg8::MoeOrder<true> S{ntl, FFE / 128, F.G, (int)blockIdx.x, tl, (const int*)(ws + WS_SLOTTOK), 0u, (unsigned)(2 * FFE * D), (unsigned)(256 * D), 8};
        pg8::EpiGU8 E{ws + WS2_R, FFE};
        pg8::gemm_phase<pg8::EpiGU8, pg8::MoeOrder<true>, true, 1, false, false>(F.lds, g, S, E);
    } SEAM(9);
    if (IN(10)) {
        const int ntl = ((const int*)(ws + WS_TILEE))[300]; LAS int* tl = (LAS int*)(F.lds + pg8::STAGE_BYTES + 8192);
        { int t_ = F.wave * 64 + lane_id(); asm volatile("" : "+v"(t_)); for (int i = t_; i < ntl; i += NWAVES * 64) tl[i] = ((const int*)(ws + WS_TILEE))[i]; }
        __syncthreads();
        pg8::Gemm g{(const bf16*)(ws + WS2_R), (const bf16*)(ws + WS_WED), FFE, FFE, FFE};
        pg8::MoeOrder<false> S{ntl, D / 256, F.G, (int)blockIdx.x, tl, nullptr, (unsigned)(256 * FFE), (unsigned)(D * FFE), (unsigned)(256 * FFE), 8};
        pg8::EpiMoeD E{(bf16*)F.out, (const int2*)(ws + WS_SLOTINFO), 1.0f / 2048.0f};
        pg8::gemm_phase<pg8::EpiMoeD, pg8::MoeOrder<false>, true, 1>(F.lds, g, S, E);
    } SEAM(10);
    if (IN(11)) { REFRESH(); final_phase(F); }
#undef IN
#undef REFRESH
#undef SEAM
}

static int mk_grid = 0;
static bool mk_setup() {
    if (mk_grid == 0) {
        int dev = 0, cus = 0;
        if (hipGetDevice(&dev) != hipSuccess || hipDeviceGetAttribute(&cus, hipDeviceAttributeMultiprocessorCount, dev) != hipSuccess) { fprintf(stderr, "mk_setup: device query failed\n"); mk_grid = -1; return false; }
        if (hipFuncSetAttribute((const void*)mk_fwd, hipFuncAttributeMaxDynamicSharedMemorySize, LDS_BYTES) != hipSuccess) { fprintf(stderr, "mk_setup: hipFuncSetAttribute failed\n"); mk_grid = -1; return false; }
        int per_cu = 0;
        if (hipOccupancyMaxActiveBlocksPerMultiprocessor(&per_cu, (const void*)mk_fwd, NWAVES * 64, LDS_BYTES) != hipSuccess || per_cu < 1) fprintf(stderr, "mk_setup: occupancy query reports %d\n", per_cu);
        (void)hipGetLastError();
        mk_grid = cus;
    }
    return mk_grid > 0;
}
static void mk_launch(void* const* d_in, void* d_out, void* d_ws, int lo, int hi, hipStream_t stream) {
    Args a{};
    for (int i = 0; i < 18; ++i) a.in[i] = (const float*)d_in[i];
    a.out = (float*)d_out; a.ws = (unsigned char*)d_ws; a.ph_lo = lo; a.ph_hi = hi; a.use_bar = (hi - lo > 1) ? 1 : 0; a.pad = 0;
    hipLaunchKernelGGL(mk_fwd, dim3(mk_grid), dim3(NWAVES * 64), LDS_BYTES, stream, a);
}

extern "C" void kernel_launch(void* const* d_in, const int* in_sizes, int n_in, void* d_out, int out_size, void* d_ws, size_t ws_size, hipStream_t stream) {
    if (n_in != 18 || in_sizes[0] != M * D || out_size != M * D || ws_size < WS2_END) { fprintf(stderr, "kernel_launch: unexpected shapes (n_in %d, ws %zu < %zu); nothing launched\n", n_in, ws_size, (size_t)WS2_END); return; }
    if (!mk_setup()) return;
    (void)hipMemsetAsync((unsigned char*)d_ws + WS_CTL, 0, CTL_ZERO_BYTES, stream);
    mk_launch(d_in, d_out, d_ws, 0, N_PHASES, stream);
}
```
